# Optimizing an MI355X kernel written in HIP

```python
import math
import jax
import jax.numpy as jnp
from jax import lax
import numpy as np

D_MODEL = 1024
BATCH = 8
SEQ = 2048
DEPTH = 1

N_SUBLAYERS = 3
ADA_COLS = 3 * N_SUBLAYERS * D_MODEL
D_FF = 2816
MLA_HEADS = 8
MLA_NOPE_DIM = 64
MLA_ROPE_DIM = 32
MLA_QK_DIM = MLA_NOPE_DIM + MLA_ROPE_DIM
MLA_V_DIM = 64
MLA_Q_LORA = 384
MLA_KV_LORA = 256
MLA_ROPE_THETA = 10000.0
MLA_WIDTH = MLA_HEADS * MLA_V_DIM
DIFF_HEADS = 4
DIFF_HEAD_DIM = 64
DIFF_V_DIM = 2 * DIFF_HEAD_DIM
DIFF_WIDTH = DIFF_HEADS * DIFF_V_DIM
ROPE_THETA = 500000.0
ROT_DIM = DIFF_HEAD_DIM // 4
N_BRANCHES = 2
IN_SIZES = (MLA_Q_LORA, MLA_KV_LORA, MLA_ROPE_DIM, DIFF_WIDTH, DIFF_WIDTH, DIFF_WIDTH, N_BRANCHES * D_MODEL)
IN_COLS = sum(IN_SIZES)
IN_SPLIT_POINTS = tuple(int(v) for v in np.cumsum(IN_SIZES)[:-1])
Q_BLOCK = 128
NORM_EPS = 1e-6

kernel_name = 'hybrid_mla_diffattn_macaron_adaln_block'


def rmsnorm(x, gain):
    xf = x.astype(jnp.float32)
    y = xf * lax.rsqrt(jnp.mean(xf * xf, axis=-1, keepdims=True) + NORM_EPS)
    return (y * gain.astype(jnp.float32)).astype(x.dtype)


def rope(x, pos, theta):
    half = x.shape[-1] // 2
    freqs = 1.0 / (theta ** (jnp.arange(half, dtype=jnp.float32) / half))
    ang = pos.astype(jnp.float32)[..., None] * freqs
    ang = ang.reshape(ang.shape[:2] + (1,) * (x.ndim - 3) + (half,))
    cos, sin = jnp.cos(ang), jnp.sin(ang)
    xf = x.astype(jnp.float32)
    x1, x2 = xf[..., :half], xf[..., half:]
    return jnp.concatenate([x1 * cos - x2 * sin, x2 * cos + x1 * sin], axis=-1).astype(x.dtype)


def partial_rope(x, pos):
    return jnp.concatenate([rope(x[..., :ROT_DIM], pos, ROPE_THETA), x[..., ROT_DIM:]], axis=-1)


def swiglu(x, w_gate, w_up, w_down):
    return (jax.nn.silu(x @ w_gate) * (x @ w_up)) @ w_down


def _to_blocks(t):
    b, s = t.shape[:2]
    return jnp.moveaxis(t.reshape((b, s // Q_BLOCK, Q_BLOCK) + t.shape[2:]), 1, 0)


def _from_blocks(t):
    nb, b, q = t.shape[:3]
    return jnp.moveaxis(t, 0, 1).reshape((b, nb * q) + t.shape[3:])


def softmax_attention(q, k, v, scale):
    def block(qb):
        s = jnp.einsum('bqhd,bkhd->bhqk', qb, k).astype(jnp.float32) * scale
        p = jax.nn.softmax(s, axis=-1).astype(v.dtype)
        return jnp.einsum('bhqk,bkhd->bqhd', p, v)
    return _from_blocks(lax.map(block, _to_blocks(q)))


def differential_attention(q1, q2, k1, k2, v, lam, scale):
    def block(qs):
        q1b, q2b = qs
        s1 = jnp.einsum('bqhd,bkhd->bhqk', q1b, k1).astype(jnp.float32) * scale
        s2 = jnp.einsum('bqhd,bkhd->bhqk', q2b, k2).astype(jnp.float32) * scale
        p = jax.nn.softmax(s1, axis=-1) - lam * jax.nn.softmax(s2, axis=-1)
        return jnp.einsum('bhqk,bkhd->bqhd', p.astype(v.dtype), v)
    return _from_blocks(lax.map(block, (_to_blocks(q1), _to_blocks(q2))))


def mla_mixer(z_q, z_kv, k_rope, pos, q_norm, w_uq, kv_norm, w_ukv, q_gain, k_gain):
    b, s, _ = z_q.shape
    q = (rmsnorm(z_q, q_norm) @ w_uq).reshape(b, s, MLA_HEADS, MLA_QK_DIM)
    kv = (rmsnorm(z_kv, kv_norm) @ w_ukv).reshape(b, s, MLA_HEADS, MLA_NOPE_DIM + MLA_V_DIM)
    k_nope, v = kv[..., :MLA_NOPE_DIM], kv[..., MLA_NOPE_DIM:]
    k_pe = jnp.broadcast_to(k_rope[:, :, None, :], (b, s, MLA_HEADS, MLA_ROPE_DIM))
    k = jnp.concatenate([k_nope, k_pe], axis=-1)
    q = rmsnorm(q, q_gain)
    k = rmsnorm(k, k_gain)
    q = jnp.concatenate([q[..., :MLA_NOPE_DIM], rope(q[..., MLA_NOPE_DIM:], pos, MLA_ROPE_THETA)], axis=-1)
    k = jnp.concatenate([k[..., :MLA_NOPE_DIM], rope(k[..., MLA_NOPE_DIM:], pos, MLA_ROPE_THETA)], axis=-1)
    o = softmax_attention(q, k, v, 1.0 / math.sqrt(MLA_QK_DIM))
    return o.reshape(b, s, MLA_WIDTH)


def diff_lambda_init(layer_idx):
    return 0.8 - 0.6 * math.exp(-0.3 * layer_idx)


def diff_mixer(z_q, z_k, z_v, pos, q_gain, k_gain, lq1, lk1, lq2, lk2, subln, lambda_init):
    b, s, _ = z_q.shape
    q = z_q.reshape(b, s, DIFF_HEADS, 2, DIFF_HEAD_DIM)
    k = z_k.reshape(b, s, DIFF_HEADS, 2, DIFF_HEAD_DIM)
    v = z_v.reshape(b, s, DIFF_HEADS, DIFF_V_DIM)
    q = partial_rope(rmsnorm(q, q_gain), pos)
    k = partial_rope(rmsnorm(k, k_gain), pos)
    f32 = jnp.float32
    lam = (jnp.exp(jnp.sum(lq1.astype(f32) * lk1.astype(f32)))
           - jnp.exp(jnp.sum(lq2.astype(f32) * lk2.astype(f32))) + lambda_init)
    o = differential_attention(q[..., 0, :], q[..., 1, :], k[..., 0, :], k[..., 1, :], v,
                               lam, 1.0 / math.sqrt(DIFF_HEAD_DIM))
    o = rmsnorm(o, subln) * (1.0 - lambda_init)
    return o.reshape(b, s, DIFF_WIDTH)


def setup_inputs(seed: int = 0) -> dict:
    key = jax.random.key(seed)
    ks = iter(jax.random.split(key, 40))
    L, D = DEPTH, D_MODEL

    def w(shape, fan_in, gain=1.0):
        return gain * fan_in ** -0.5 * jax.random.normal(next(ks), shape, jnp.float32)

    def g(shape):
        return 1.0 + 0.05 * jax.random.normal(next(ks), shape, jnp.float32)

    def small(shape, scale):
        return scale * jax.random.normal(next(ks), shape, jnp.float32)

    x = jax.random.normal(next(ks), (BATCH, SEQ, D), jnp.float32)
    c = jax.random.normal(next(ks), (BATCH, D), jnp.float32)
    positions = (jnp.arange(SEQ, dtype=jnp.int32)[None, :]
                 + jax.random.randint(next(ks), (BATCH, 1), 0, SEQ, dtype=jnp.int32))
    return {
        'x': x,
        'c': c,
        'positions': positions,
        'w_ada': w((L, D, ADA_COLS), D, 0.5),
        'b_ada': small((L, ADA_COLS), 0.02),
        'ffn1_norm': g((L, D)),
        'ffn1_w_gate': w((L, D, D_FF), D),
        'ffn1_w_up': w((L, D, D_FF), D),
        'ffn1_w_down': w((L, D_FF, D), D_FF),
        'mix_norm': g((L, D)),
        'w_in': w((L, D, IN_COLS), D),
        'mla_q_norm': g((L, MLA_Q_LORA)),
        'mla_w_uq': w((L, MLA_Q_LORA, MLA_HEADS * MLA_QK_DIM), MLA_Q_LORA),
        'mla_kv_norm': g((L, MLA_KV_LORA)),
        'mla_w_ukv': w((L, MLA_KV_LORA, MLA_HEADS * (MLA_NOPE_DIM + MLA_V_DIM)), MLA_KV_LORA),
        'mla_q_gain': g((L, MLA_QK_DIM)),
        'mla_k_gain': g((L, MLA_QK_DIM)),
        'mla_w_o': w((L, MLA_WIDTH, D), MLA_WIDTH),
        'diff_q_gain': g((L, DIFF_HEAD_DIM)),
        'diff_k_gain': g((L, DIFF_HEAD_DIM)),
        'diff_lambda_q1': small((L, DIFF_HEAD_DIM), 0.1),
        'diff_lambda_k1': small((L, DIFF_HEAD_DIM), 0.1),
        'diff_lambda_q2': small((L, DIFF_HEAD_DIM), 0.1),
        'diff_lambda_k2': small((L, DIFF_HEAD_DIM), 0.1),
        'diff_subln': g((L, DIFF_V_DIM)),
        'diff_w_o': w((L, DIFF_WIDTH, D), DIFF_WIDTH),
        'w_out': w((L, D, D), D),
        'ffn2_norm': g((L, D)),
        'ffn2_w_gate': w((L, D, D_FF), D),
        'ffn2_w_up': w((L, D, D_FF), D),
        'ffn2_w_down': w((L, D_FF, D), D_FF),
        'final_norm': g((L, D)),
    }


def reference(x, c, positions, w_ada, b_ada, ffn1_norm, ffn1_w_gate, ffn1_w_up, ffn1_w_down,
              mix_norm, w_in, mla_q_norm, mla_w_uq, mla_kv_norm, mla_w_ukv, mla_q_gain, mla_k_gain,
              mla_w_o, diff_q_gain, diff_k_gain, diff_lambda_q1, diff_lambda_k1, diff_lambda_q2,
              diff_lambda_k2, diff_subln, diff_w_o, w_out, ffn2_norm, ffn2_w_gate, ffn2_w_up,
              ffn2_w_down, final_norm):
    h = x
    cond = jax.nn.silu(c)
    for l in range(DEPTH):
        mod = cond @ w_ada[l] + b_ada[l]
        sh1, sc1, gt1, sh2, sc2, gt2, sh3, sc3, gt3 = [
            m[:, None, :] for m in jnp.split(mod, 3 * N_SUBLAYERS, axis=-1)]

        n = rmsnorm(h, ffn1_norm[l]) * (1 + sc1) + sh1
        h = h + 0.5 * gt1 * swiglu(n, ffn1_w_gate[l], ffn1_w_up[l], ffn1_w_down[l])

        n = rmsnorm(h, mix_norm[l]) * (1 + sc2) + sh2
        z = n @ w_in[l]
        zq_a, zkv_a, krope_a, zq_b, zk_b, zv_b, gate_logits = jnp.split(z, IN_SPLIT_POINTS, axis=-1)
        y_a = mla_mixer(zq_a, zkv_a, krope_a, positions, mla_q_norm[l], mla_w_uq[l],
                        mla_kv_norm[l], mla_w_ukv[l], mla_q_gain[l], mla_k_gain[l]) @ mla_w_o[l]
        y_b = diff_mixer(zq_b, zk_b, zv_b, positions, diff_q_gain[l], diff_k_gain[l],
                         diff_lambda_q1[l], diff_lambda_k1[l], diff_lambda_q2[l], diff_lambda_k2[l],
                         diff_subln[l], diff_lambda_init(l)) @ diff_w_o[l]
        gate_a, gate_b = jnp.split(jax.nn.sigmoid(gate_logits), N_BRANCHES, axis=-1)
        h = h + gt2 * ((gate_a * y_a + gate_b * y_b) @ w_out[l])

        n = rmsnorm(h, ffn2_norm[l]) * (1 + sc3) + sh3
        h = h + 0.5 * gt3 * swiglu(n, ffn2_w_gate[l], ffn2_w_up[l], ffn2_w_down[l])

        h = rmsnorm(h, final_norm[l])
    return h
```

```cpp
#include <hip/hip_runtime.h>
#include <cstdio>
#include <cstdint>

constexpr int BATCH = 8, SEQ = 2048, D = 1024, M = BATCH * SEQ, DFF = 2816, ADA = 9 * D;
constexpr int QLORA = 384, KVLORA = 256, ROPE_A = 32, MLA_H = 8, MLA_QK = 96, MLA_NOPE = 64, MLA_V = 64;
constexpr int DF_H = 4, DF_D = 64, DF_V = 128, ROT = 16;
constexpr int IN_COLS = 4256;
constexpr int ZA_LD = 768, ZB_LD = 1536, ZG_LD = 2048;
constexpr float EPS = 1e-6f;
constexpr float LOG2E = 1.4426950408889634f;
constexpr float C2_MLA = 0.10206207261596577f * LOG2E;
constexpr float C2_DF = 0.125f * LOG2E;
constexpr float LAMBDA_INIT = 0.2f;
constexpr int NWAVES = 8, NTHR = 512;

constexpr size_t MiB = 1u << 20;
constexpr size_t WS_CTL = 0, CTL_ZERO_BYTES = 1 * MiB;
constexpr size_t WS_MOD = 1 * MiB;
constexpr size_t WS_WFFN = 2 * MiB;
constexpr size_t WS_VM = 2 * MiB;
constexpr size_t WS_XN = 33 * MiB;
constexpr size_t WS_OM = 33 * MiB, WS_OD = 49 * MiB;
constexpr size_t WS_BIG = 65 * MiB;
constexpr size_t WS_ACT = WS_BIG;
constexpr size_t WS_ZG = WS_BIG;
constexpr size_t WS_ZB = WS_BIG + 64 * MiB;
constexpr size_t WS_ZA = WS_BIG + 112 * MiB;
constexpr size_t WS_QM = WS_BIG + 136 * MiB;
constexpr size_t WS_KM = WS_BIG + 160 * MiB;
constexpr size_t WS_MRG = WS_QM;
constexpr size_t WS_END = WS_BIG + 184 * MiB;
constexpr int CW_BAR = 4096;

constexpr int LDS_BYTES = 147456, RING_BYTES = 131072, LDSCTL_OFF = RING_BYTES, MISC_OFF = LDSCTL_OFF + 320;

#define GAS __attribute__((address_space(1)))
#define LAS __attribute__((address_space(3)))
typedef unsigned short bf16;
typedef float f32x4 __attribute__((ext_vector_type(4)));

__device__ __forceinline__ float bf2f(bf16 v) { return __uint_as_float(((unsigned)v) << 16); }
__device__ __forceinline__ bf16 f2bf(float f) { unsigned u = __float_as_uint(f); return (bf16)((u + 0x7fffu + ((u >> 16) & 1u)) >> 16); }
__device__ __forceinline__ float silu_f(float v) { return v / (1.f + __expf(-v)); }
__device__ __forceinline__ float sigmoid_f(float v) { return 1.f / (1.f + __expf(-v)); }
__device__ __forceinline__ float wave_sum(float v) {
#pragma unroll
    for (int o = 1; o < 64; o <<= 1) v += __shfl_xor(v, o);
    return v;
}
__device__ __forceinline__ void sincos_red(float ang, float& sn, float& cs) {
    double t = (double)ang * 0.15915494309189535;
    t -= __builtin_rint(t);
    const float r = (float)t;
    sn = __builtin_amdgcn_sinf(r); cs = __builtin_amdgcn_cosf(r);
}

#define XB_TMO      128
#define XB_XCNT(j)  (256  + 64 * (j))
#define XB_XSUB(j)  (1280 + 64 * (j))
#define XB_XGEN(j)  (2304 + 64 * (j))
#define XB_TOP      3328
#define XB_TOPGEN   3392
#define XCD_BAR_WORDS 3456
#define XB_SPIN_CAP (1u << 24)
__device__ __forceinline__ unsigned xb_ld(unsigned* p)              { return __hip_atomic_load(p, __ATOMIC_RELAXED, __HIP_MEMORY_SCOPE_AGENT); }
__device__ __forceinline__ unsigned xb_add(unsigned* p, unsigned v) { return __hip_atomic_fetch_add(p, v, __ATOMIC_RELAXED, __HIP_MEMORY_SCOPE_AGENT); }
__device__ __forceinline__ unsigned xb_xcc_id() { return (unsigned)__builtin_amdgcn_s_getreg((3 << 11) | 20) & 0xFu; }
#define XB_SPIN(cond, bar) do { unsigned _sp = 0; while (cond) { __builtin_amdgcn_s_sleep(1); \
    if ((++_sp & 255u) == 0u) { if (xb_ld(&(bar)[XB_TMO])) break; if (_sp > XB_SPIN_CAP) { atomicAdd(&(bar)[XB_TMO], 1u); break; } } } } while (0)
struct XcdBarrier { unsigned* bar; unsigned x; volatile LAS unsigned* st; };
__device__ __forceinline__ XcdBarrier xcd_barrier_post(unsigned* bar, volatile LAS unsigned* st) {
    XcdBarrier b; b.bar = bar; b.x = xb_xcc_id(); b.st = st;
    if (threadIdx.x == 0) (void)xb_add(&bar[XB_XCNT(b.x)], 1u);
    return b;
}
__device__ __forceinline__ void xcd_barrier_complete(unsigned* bar, unsigned x, unsigned& nloc, unsigned& nx) {
    const unsigned G = gridDim.x * gridDim.y * gridDim.z;
    unsigned sum, cnt, mine, sp = 0u;
    for (;;) {
        sum = 0u; cnt = 0u; mine = 0u;
#pragma unroll
        for (unsigned j = 0; j < 16; ++j) { const unsigned c = xb_ld(&bar[XB_XCNT(j)]); sum += c; cnt += (c > 0u) ? 1u : 0u; mine = (j == x) ? c : mine; }
        if (sum == G) break;
        __builtin_amdgcn_s_sleep(1);
        if ((++sp & 255u) == 0u) { if (xb_ld(&bar[XB_TMO])) break; if (sp > XB_SPIN_CAP) { atomicAdd(&bar[XB_TMO], 1u); break; } }
    }
    nloc = mine > 0u ? mine : 1u; nx = cnt > 0u ? cnt : 1u;
}
__device__ __forceinline__ void xcd_barrier(const XcdBarrier& b) {
    asm volatile("s_waitcnt vmcnt(0)" ::: "memory");
    __syncthreads();
    if (threadIdx.x == 0) {
        unsigned* bar = b.bar;
        __builtin_amdgcn_s_waitcnt(0);
        unsigned nloc = b.st[0], nx = b.st[1];
        if (nloc == 0u) { xcd_barrier_complete(bar, b.x, nloc, nx); b.st[0] = nloc; b.st[1] = nx; }
        const unsigned old = xb_add(&bar[XB_XSUB(b.x)], 1u);
        const unsigned gen = old / nloc;
        if (old + 1u == (gen + 1u) * nloc) {
            __builtin_amdgcn_fence(__ATOMIC_RELEASE, "agent");
            asm volatile("s_waitcnt vmcnt(0)" ::: "memory");
            const unsigned og = xb_add(&bar[XB_TOP], 1u);
            const unsigned tg = og / nx;
            if (og + 1u == (tg + 1u) * nx) xb_add(&bar[XB_TOPGEN], 1u);
            else XB_SPIN(xb_ld(&bar[XB_TOPGEN]) == tg, bar);
            __builtin_amdgcn_fence(__ATOMIC_ACQUIRE, "agent");
            xb_add(&bar[XB_XGEN(b.x)], 1u);
            asm volatile("s_waitcnt vmcnt(0)" ::: "memory");
        } else {
            XB_SPIN(xb_ld(&bar[XB_XGEN(b.x)]) == gen, bar);
            __builtin_amdgcn_fence(__ATOMIC_ACQUIRE, "agent");
            asm volatile("s_waitcnt vmcnt(0)" ::: "memory");
        }
    }
    __syncthreads();
}

struct Args { const void* in[32]; float* out; unsigned char* ws; int ph_lo, ph_hi; };

struct Frame {
    LAS unsigned char* lds;
    int tid, lane, wave, G, bid;
    const void* const* in;
    unsigned char* ws; float* H;
};
#define FIN(i) ((const float*)F.in[i])
#define F_x FIN(0)
#define F_c FIN(1)
#define F_pos ((const int*)F.in[2])
#define F_w_ada FIN(3)
#define F_b_ada FIN(4)
#define F_ffn1_norm FIN(5)
#define F_ffn1_wg FIN(6)
#define F_ffn1_wu FIN(7)
#define F_ffn1_wd FIN(8)
#define F_mix_norm FIN(9)
#define F_w_in FIN(10)
#define F_q_norm FIN(11)
#define F_w_uq FIN(12)
#define F_kv_norm FIN(13)
#define F_w_ukv FIN(14)
#define F_q_gain FIN(15)
#define F_k_gain FIN(16)
#define F_mla_wo FIN(17)
#define F_dq_gain FIN(18)
#define F_dk_gain FIN(19)
#define F_lq1 FIN(20)
#define F_lk1 FIN(21)
#define F_lq2 FIN(22)
#define F_lk2 FIN(23)
#define F_subln FIN(24)
#define F_diff_wo FIN(25)
#define F_w_out FIN(26)
#define F_ffn2_norm FIN(27)
#define F_ffn2_wg FIN(28)
#define F_ffn2_wu FIN(29)
#define F_ffn2_wd FIN(30)
#define F_final_norm FIN(31)
#define F_MOD ((float*)(F.ws + WS_MOD))
#define F_XN ((bf16*)(F.ws + WS_XN))
#define F_ACT ((bf16*)(F.ws + WS_ACT))
#define F_ZA ((bf16*)(F.ws + WS_ZA))
#define F_ZB ((bf16*)(F.ws + WS_ZB))
#define F_ZG ((bf16*)(F.ws + WS_ZG))
#define F_QM ((bf16*)(F.ws + WS_QM))
#define F_KM ((bf16*)(F.ws + WS_KM))
#define F_VM ((bf16*)(F.ws + WS_VM))
#define F_OM ((bf16*)(F.ws + WS_OM))
#define F_OD ((bf16*)(F.ws + WS_OD))
#define F_MRG ((bf16*)(F.ws + WS_MRG))

__device__ __forceinline__ void ph_adaln(Frame& F) {
    LAS float* condL = (LAS float*)F.lds;
    LAS float* red = condL + 8 * 1024;
    for (int i = F.tid; i < 8 * 1024; i += NTHR) condL[i] = silu_f(F_c[i]);
    __syncthreads();
    constexpr int CPB = ADA / 256;
    for (int it = F.bid; it < 256; it += F.G) {
        const int n0 = it * CPB, col = F.tid % CPB, kg = F.tid / CPB;
        float acc[8];
#pragma unroll
        for (int b = 0; b < 8; ++b) acc[b] = 0.f;
        if (kg < 14) for (int k = kg; k < D; k += 14) { const float w = F_w_ada[(size_t)k * ADA + n0 + col];
#pragma unroll
            for (int b = 0; b < 8; ++b) acc[b] += condL[b * 1024 + k] * w; }
        if (kg < 14) {
#pragma unroll
            for (int b = 0; b < 8; ++b) red[(kg * CPB + col) * 8 + b] = acc[b]; }
        __syncthreads();
        if (F.tid < CPB * 8) { const int cc = F.tid / 8, b = F.tid % 8; float s = F_b_ada[n0 + cc];
            for (int g = 0; g < 14; ++g) s += red[(g * CPB + cc) * 8 + b];
            F_MOD[b * ADA + n0 + cc] = s; }
        __syncthreads();
    }
}
__device__ __forceinline__ void ph_norm_mod(Frame& F, const float* src, const float* gain, int sh_off, int sc_off, bf16* dst) {
    const int gw = F.bid * NWAVES + F.wave, NGW = F.G * NWAVES;
    for (int m = gw; m < M; m += NGW) {
        const int b = m / SEQ;
        const f32x4* xr = (const f32x4*)(src + (size_t)m * D) + F.lane;
        f32x4 v[4]; float s = 0.f;
#pragma unroll
        for (int j = 0; j < 4; ++j) { v[j] = xr[64 * j]; s += (v[j].x * v[j].x + v[j].y * v[j].y) + (v[j].z * v[j].z + v[j].w * v[j].w); }
        const float rstd = 1.f / sqrtf(wave_sum(s) * (1.f / D) + EPS);
#pragma unroll
        for (int j = 0; j < 4; ++j) {
            const int c0 = 4 * F.lane + 256 * j;
            const f32x4 g = *(const f32x4*)(gain + c0), sc = *(const f32x4*)(F_MOD + b * ADA + sc_off + c0), sh = *(const f32x4*)(F_MOD + b * ADA + sh_off + c0);
            const f32x4 o = v[j] * rstd * g * (1.f + sc) + sh;
            ushort4 w; w.x = f2bf(o.x); w.y = f2bf(o.y); w.z = f2bf(o.z); w.w = f2bf(o.w);
            *(ushort4*)(dst + (size_t)m * D + c0) = w;
        }
    }
}
__device__ __forceinline__ void ph_final_norm(Frame& F) {
    const int gw = F.bid * NWAVES + F.wave, NGW = F.G * NWAVES;
    for (int m = gw; m < M; m += NGW) {
        f32x4* xr = (f32x4*)(F.H + (size_t)m * D) + F.lane;
        f32x4 v[4]; float s = 0.f;
#pragma unroll
        for (int j = 0; j < 4; ++j) { v[j] = xr[64 * j]; s += (v[j].x * v[j].x + v[j].y * v[j].y) + (v[j].z * v[j].z + v[j].w * v[j].w); }
        const float rstd = 1.f / sqrtf(wave_sum(s) * (1.f / D) + EPS);
#pragma unroll
        for (int j = 0; j < 4; ++j) { const f32x4 g = *(const f32x4*)(F_final_norm + 4 * F.lane + 256 * j); xr[64 * j] = v[j] * rstd * g; }
    }
}

template <int R, int NMAT, class Epi>
__device__ __forceinline__ void naive_gemm(Frame& F, const bf16* A0, const bf16* A1, int lda, int K, const float* W0, const float* W1, int ldw, int N, const Epi& epi) {
    LAS float* L0 = (LAS float*)F.lds;
    const bool sameA = (A1 == A0) || (NMAT == 1);
    LAS float* L1 = sameA ? L0 : L0 + (size_t)K * R;
    for (int rb = F.bid; rb < M / R; rb += F.G) {
        const int r0 = rb * R;
        for (int i = F.tid; i < R * K; i += NTHR) { const int r = i / K, k = i % K; L0[k * R + r] = bf2f(A0[(size_t)(r0 + r) * lda + k]); }
        if (!sameA) for (int i = F.tid; i < R * K; i += NTHR) { const int r = i / K, k = i % K; L1[k * R + r] = bf2f(A1[(size_t)(r0 + r) * lda + k]); }
        __syncthreads();
        for (int n = F.tid; n < N; n += NTHR) {
            float acc0[R], acc1[R];
#pragma unroll
            for (int r = 0; r < R; ++r) { acc0[r] = 0.f; acc1[r] = 0.f; }
#pragma unroll 4
            for (int k = 0; k < K; ++k) {
                const float w0 = W0[(size_t)k * ldw + n];
                float w1 = 0.f; if (NMAT == 2) w1 = W1[(size_t)k * ldw + n];
#pragma unroll
                for (int r4 = 0; r4 < R / 4; ++r4) {
                    const f32x4 a = *(const LAS f32x4*)(L0 + k * R + 4 * r4);
                    acc0[4 * r4 + 0] += a.x * w0; acc0[4 * r4 + 1] += a.y * w0; acc0[4 * r4 + 2] += a.z * w0; acc0[4 * r4 + 3] += a.w * w0;
                    if (NMAT == 2) { const f32x4 a1 = *(const LAS f32x4*)(L1 + k * R + 4 * r4);
                        acc1[4 * r4 + 0] += a1.x * w1; acc1[4 * r4 + 1] += a1.y * w1; acc1[4 * r4 + 2] += a1.z * w1; acc1[4 * r4 + 3] += a1.w * w1; }
                }
            }
#pragma unroll
            for (int r = 0; r < R; ++r) epi(r0 + r, n, acc0[r], acc1[r]);
        }
        __syncthreads();
    }
}

__device__ __forceinline__ void ph_mla_prep(Frame& F) {
    constexpr int R = 16;
    LAS float* A = (LAS float*)F.lds;
    LAS float* SC = A + 384 * R;
    LAS float* OUT = SC + 64;
    for (int rb = F.bid; rb < M / R; rb += F.G) {
        const int r0 = rb * R;
        for (int i = F.tid; i < R * QLORA; i += NTHR) { const int r = i / QLORA, k = i % QLORA; A[k * R + r] = bf2f(F_ZA[(size_t)(r0 + r) * ZA_LD + k]); }
        __syncthreads();
        if (F.tid < R) { float ss = 0.f; for (int k = 0; k < QLORA; ++k) { const float v = A[k * R + F.tid]; ss += v * v; } SC[F.tid] = 1.f / sqrtf(ss * (1.f / QLORA) + EPS); }
        __syncthreads();
        for (int i = F.tid; i < R * QLORA; i += NTHR) { const int r = i % R, k = i / R; A[k * R + r] *= SC[r] * F_q_norm[k]; }
        __syncthreads();
        for (int n = F.tid; n < MLA_H * MLA_QK; n += NTHR) {
            float acc[R];
#pragma unroll
            for (int r = 0; r < R; ++r) acc[r] = 0.f;
#pragma unroll 4
            for (int k = 0; k < QLORA; ++k) { const float w = F_w_uq[(size_t)k * (MLA_H * MLA_QK) + n];
#pragma unroll
                for (int r4 = 0; r4 < R / 4; ++r4) { const f32x4 a = *(const LAS f32x4*)(A + k * R + 4 * r4);
                    acc[4 * r4] += a.x * w; acc[4 * r4 + 1] += a.y * w; acc[4 * r4 + 2] += a.z * w; acc[4 * r4 + 3] += a.w * w; } }
#pragma unroll
            for (int r = 0; r < R; ++r) OUT[r * 1024 + n] = acc[r];
        }
        __syncthreads();
        if (F.tid < R * MLA_H) {
            const int r = F.tid / MLA_H, h = F.tid % MLA_H, row = r0 + r;
            const LAS float* q = OUT + r * 1024 + h * MLA_QK;
            float ss = 0.f; for (int d = 0; d < MLA_QK; ++d) ss += q[d] * q[d];
            const float s = 1.f / sqrtf(ss * (1.f / MLA_QK) + EPS) * C2_MLA;
            bf16* dst = F_QM + (size_t)row * 768 + h * MLA_QK;
            for (int d = 0; d < MLA_NOPE; ++d) dst[d] = f2bf(q[d] * s * F_q_gain[d]);
            const float p = (float)F_pos[row];
            for (int i = 0; i < 16; ++i) {
                const float freq = exp2f(-13.287712379549449f * (float)i * (1.f / 16.f));
                float sn, cs; sincos_red(p * freq, sn, cs);
                const float x1 = q[64 + i] * s * F_q_gain[64 + i], x2 = q[80 + i] * s * F_q_gain[80 + i];
                dst[64 + i] = f2bf(x1 * cs - x2 * sn); dst[80 + i] = f2bf(x2 * cs + x1 * sn);
            }
        }
        __syncthreads();
        for (int i = F.tid; i < R * KVLORA; i += NTHR) { const int r = i / KVLORA, k = i % KVLORA; A[k * R + r] = bf2f(F_ZA[(size_t)(r0 + r) * ZA_LD + QLORA + k]); }
        __syncthreads();
        if (F.tid < R) { float ss = 0.f; for (int k = 0; k < KVLORA; ++k) { const float v = A[k * R + F.tid]; ss += v * v; } SC[F.tid] = 1.f / sqrtf(ss * (1.f / KVLORA) + EPS); }
        __syncthreads();
        for (int i = F.tid; i < R * KVLORA; i += NTHR) { const int r = i % R, k = i / R; A[k * R + r] *= SC[r] * F_kv_norm[k]; }
        __syncthreads();
        for (int n = F.tid; n < 1024; n += NTHR) {
            float acc[R];
#pragma unroll
            for (int r = 0; r < R; ++r) acc[r] = 0.f;
#pragma unroll 4
            for (int k = 0; k < KVLORA; ++k) { const float w = F_w_ukv[(size_t)k * 1024 + n];
#pragma unroll
                for (int r4 = 0; r4 < R / 4; ++r4) { const f32x4 a = *(const LAS f32x4*)(A + k * R + 4 * r4);
                    acc[4 * r4] += a.x * w; acc[4 * r4 + 1] += a.y * w; acc[4 * r4 + 2] += a.z * w; acc[4 * r4 + 3] += a.w * w; } }
#pragma unroll
            for (int r = 0; r < R; ++r) OUT[r * 1024 + n] = acc[r];
        }
        __syncthreads();
        if (F.tid < R * MLA_H) {
            const int r = F.tid / MLA_H, h = F.tid % MLA_H, row = r0 + r;
            const LAS float* kn = OUT + r * 1024 + h * 128;
            const bf16* kr = F_ZA + (size_t)row * ZA_LD + QLORA + KVLORA;
            float ss = 0.f; for (int d = 0; d < 64; ++d) ss += kn[d] * kn[d];
            for (int d = 0; d < 32; ++d) { const float v = bf2f(kr[d]); ss += v * v; }
            const float s = 1.f / sqrtf(ss * (1.f / MLA_QK) + EPS);
            bf16* dk = F_KM + (size_t)row * 768 + h * MLA_QK;
            for (int d = 0; d < 64; ++d) dk[d] = f2bf(kn[d] * s * F_k_gain[d]);
            const float p = (float)F_pos[row];
            for (int i = 0; i < 16; ++i) {
                const float freq = exp2f(-13.287712379549449f * (float)i * (1.f / 16.f));
                float sn, cs; sincos_red(p * freq, sn, cs);
                const float x1 = bf2f(kr[i]) * s * F_k_gain[64 + i], x2 = bf2f(kr[16 + i]) * s * F_k_gain[80 + i];
                dk[64 + i] = f2bf(x1 * cs - x2 * sn); dk[80 + i] = f2bf(x2 * cs + x1 * sn);
            }
            bf16* dv = F_VM + (size_t)row * 512 + h * 64;
            for (int d = 0; d < 64; ++d) dv[d] = f2bf(kn[64 + d]);
        }
        __syncthreads();
    }
}
__device__ __forceinline__ void ph_diff_prep(Frame& F) {
    const int gt = F.bid * NTHR + F.tid, NGT = F.G * NTHR;
    for (int it = gt; it < M * 16; it += NGT) {
        const int row = it >> 4, ch = it & 15;
        bf16* p = F_ZB + (size_t)row * ZB_LD + ch * 64;
        const bool isq = ch < 8;
        const float* gain = isq ? F_dq_gain : F_dk_gain;
        float ss = 0.f;
        for (int d = 0; d < 64; ++d) { const float v = bf2f(p[d]); ss += v * v; }
        const float s = 1.f / sqrtf(ss * (1.f / 64.f) + EPS) * (isq ? C2_DF : 1.f);
        const float ps = (float)F_pos[row];
        float o1[8], o2[8];
#pragma unroll
        for (int i = 0; i < 8; ++i) {
            const float freq = exp2f(-18.931568569324174f * (float)i * (1.f / 8.f));
            float sn, cs; sincos_red(ps * freq, sn, cs);
            const float x1 = bf2f(p[i]) * s * gain[i], x2 = bf2f(p[8 + i]) * s * gain[8 + i];
            o1[i] = x1 * cs - x2 * sn; o2[i] = x2 * cs + x1 * sn;
        }
        for (int d = 16; d < 64; ++d) p[d] = f2bf(bf2f(p[d]) * s * gain[d]);
#pragma unroll
        for (int i = 0; i < 8; ++i) { p[i] = f2bf(o1[i]); p[8 + i] = f2bf(o2[i]); }
    }
}

constexpr int TK = 16;
template <int DQK, int DV>
__device__ __forceinline__ void attn_sweep(Frame& F, const float (&q)[DQK / 4], float (&o)[DV / 4], float& m, float& l, const bf16* Kb, int ldk, const bf16* Vb, int ldv) {
    constexpr int QP = DQK / 4, VP = DV / 4;
    const int part = F.tid & 3;
    LAS float* KL = (LAS float*)F.lds;
    LAS float* VL = KL + TK * DQK;
    for (int t0 = 0; t0 < SEQ; t0 += TK) {
        __syncthreads();
        for (int i = F.tid; i < TK * DQK; i += NTHR) { const int j = i / DQK, d = i % DQK; KL[i] = bf2f(Kb[(size_t)(t0 + j) * ldk + d]); }
        for (int i = F.tid; i < TK * DV; i += NTHR) { const int j = i / DV, d = i % DV; VL[i] = bf2f(Vb[(size_t)(t0 + j) * ldv + d]); }
        __syncthreads();
#pragma unroll 2
        for (int j = 0; j < TK; ++j) {
            float a = 0.f;
#pragma unroll
            for (int d4 = 0; d4 < QP / 4; ++d4) { const f32x4 kv = *(const LAS f32x4*)(KL + j * DQK + part * QP + 4 * d4);
                a += q[4 * d4] * kv.x + q[4 * d4 + 1] * kv.y + q[4 * d4 + 2] * kv.z + q[4 * d4 + 3] * kv.w; }
            a += __shfl_xor(a, 1); a += __shfl_xor(a, 2);
            const float mn = fmaxf(m, a), alpha = exp2f(m - mn), p = exp2f(a - mn);
            l = l * alpha + p; m = mn;
#pragma unroll
            for (int d4 = 0; d4 < VP / 4; ++d4) { const f32x4 vv = *(const LAS f32x4*)(VL + j * DV + part * VP + 4 * d4);
                o[4 * d4] = o[4 * d4] * alpha + p * vv.x; o[4 * d4 + 1] = o[4 * d4 + 1] * alpha + p * vv.y;
                o[4 * d4 + 2] = o[4 * d4 + 2] * alpha + p * vv.z; o[4 * d4 + 3] = o[4 * d4 + 3] * alpha + p * vv.w; }
        }
    }
}
__device__ __forceinline__ void ph_attention(Frame& F) {
    const int part = F.tid & 3, qi = F.tid >> 2;
    for (int u = F.bid; u < 1536; u += F.G) {
        if (u < 1024) {
            const int b = u >> 7, h = (u >> 4) & 7, qc = u & 15;
            const int row = b * SEQ + qc * 128 + qi;
            float q[MLA_QK / 4], o[MLA_V / 4]; float m = -INFINITY, l = 0.f;
#pragma unroll
            for (int d = 0; d < MLA_QK / 4; ++d) q[d] = bf2f(F_QM[(size_t)row * 768 + h * MLA_QK + part * (MLA_QK / 4) + d]);
#pragma unroll
            for (int d = 0; d < MLA_V / 4; ++d) o[d] = 0.f;
            attn_sweep<MLA_QK, MLA_V>(F, q, o, m, l, F_KM + (size_t)b * SEQ * 768 + h * MLA_QK, 768, F_VM + (size_t)b * SEQ * 512 + h * 64, 512);
            const float il = 1.f / l;
#pragma unroll
            for (int d = 0; d < MLA_V / 4; ++d) F_OM[(size_t)row * 512 + h * 64 + part * (MLA_V / 4) + d] = f2bf(o[d] * il);
        } else {
            const int v = u - 1024, b = v >> 6, h = (v >> 4) & 3, qc = v & 15;
            const int row = b * SEQ + qc * 128 + qi;
            float lam;
            { float s1 = 0.f, s2 = 0.f; for (int d = 0; d < 64; ++d) { s1 += F_lq1[d] * F_lk1[d]; s2 += F_lq2[d] * F_lk2[d]; } lam = expf(s1) - expf(s2) + LAMBDA_INIT; }
            float q[DF_D / 4], o1[DF_V / 4], o[DF_V / 4];
            const bf16* Zb = F_ZB + (size_t)b * SEQ * ZB_LD;
            { float m = -INFINITY, l = 0.f;
#pragma unroll
              for (int d = 0; d < DF_D / 4; ++d) q[d] = bf2f(F_ZB[(size_t)row * ZB_LD + h * 128 + part * (DF_D / 4) + d]);
#pragma unroll
              for (int d = 0; d < DF_V / 4; ++d) o[d] = 0.f;
              attn_sweep<DF_D, DF_V>(F, q, o, m, l, Zb + 512 + h * 128, ZB_LD, Zb + 1024 + h * 128, ZB_LD);
              const float il = 1.f / l;
#pragma unroll
              for (int d = 0; d < DF_V / 4; ++d) o1[d] = o[d] * il; }
            { float m = -INFINITY, l = 0.f;
#pragma unroll
              for (int d = 0; d < DF_D / 4; ++d) q[d] = bf2f(F_ZB[(size_t)row * ZB_LD + h * 128 + 64 + part * (DF_D / 4) + d]);
#pragma unroll
              for (int d = 0; d < DF_V / 4; ++d) o[d] = 0.f;
              attn_sweep<DF_D, DF_V>(F, q, o, m, l, Zb + 512 + h * 128 + 64, ZB_LD, Zb + 1024 + h * 128, ZB_LD);
              const float il = lam / l;
#pragma unroll
              for (int d = 0; d < DF_V / 4; ++d) F_OD[(size_t)row * 512 + h * 128 + part * (DF_V / 4) + d] = f2bf(o1[d] - o[d] * il); }
        }
    }
}
__device__ __forceinline__ void ph_subln(Frame& F) {
    const int gt = F.bid * NTHR + F.tid, NGT = F.G * NTHR;
    for (int it = gt; it < M * 4; it += NGT) {
        bf16* p = F_OD + (size_t)(it >> 2) * 512 + (it & 3) * 128;
        float ss = 0.f;
        for (int d = 0; d < 128; ++d) { const float v = bf2f(p[d]); ss += v * v; }
        const float s = 1.f / sqrtf(ss * (1.f / 128.f) + EPS) * (1.f - LAMBDA_INIT);
        for (int d = 0; d < 128; ++d) p[d] = f2bf(bf2f(p[d]) * s * F_subln[d]);
    }
}

struct EpiSwiglu { bf16* ACT; __device__ __forceinline__ void operator()(int row, int col, float g, float u) const { ACT[(size_t)row * DFF + col] = f2bf(silu_f(g) * u); } };
struct EpiResid { float* H; const float* base; const float* MOD; int gt_off; float scale;
    __device__ __forceinline__ void operator()(int row, int col, float a, float) const { const int b = row / SEQ; H[(size_t)row * D + col] = base[(size_t)row * D + col] + scale * MOD[b * ADA + gt_off + col] * a; } };
struct EpiZ { bf16 *ZA, *ZB, *ZG;
    __device__ __forceinline__ void operator()(int row, int col, float a, float) const {
        if (col < 672) ZA[(size_t)row * ZA_LD + col] = f2bf(a);
        else if (col < 2208) ZB[(size_t)row * ZB_LD + (col - 672)] = f2bf(a);
        else ZG[(size_t)row * ZG_LD + (col - 2208)] = f2bf(a); } };
struct EpiMerge { bf16* MRG; const bf16* ZG;
    __device__ __forceinline__ void operator()(int row, int col, float ya, float yb) const {
        const float ga = sigmoid_f(bf2f(ZG[(size_t)row * ZG_LD + col])), gb = sigmoid_f(bf2f(ZG[(size_t)row * ZG_LD + 1024 + col]));
        MRG[(size_t)row * D + col] = f2bf(ga * ya + gb * yb); } };

constexpr int NPH = 15;

__global__ void __launch_bounds__(NTHR, 2) mk_fwd(Args args) {
    extern __shared__ __attribute__((aligned(16))) unsigned char lds_raw[];
    Frame F;
    F.lds = (LAS unsigned char*)lds_raw;
    F.tid = threadIdx.x; F.lane = F.tid & 63; F.wave = __builtin_amdgcn_readfirstlane(F.tid >> 6); F.G = gridDim.x; F.bid = blockIdx.x;
    unsigned char* ws = args.ws;
    F.in = args.in; F.ws = args.ws; F.H = args.out;

    for (int u = F.tid; u < (LDS_BYTES - LDSCTL_OFF) / 4; u += NTHR) ((LAS unsigned*)(F.lds + LDSCTL_OFF))[u] = 0u;
    __syncthreads();
    volatile LAS unsigned* MISC = (volatile LAS unsigned*)(F.lds + MISC_OFF);
    const bool multi = (args.ph_hi - args.ph_lo) > 1;
    XcdBarrier bar; bar.bar = (unsigned*)(ws + WS_CTL) + CW_BAR; bar.x = 0; bar.st = MISC + 8;
    if (multi) bar = xcd_barrier_post((unsigned*)(ws + WS_CTL) + CW_BAR, MISC + 8);

    const int lo = args.ph_lo, hi = args.ph_hi;
#define IN(k) (lo <= (k) && (k) < hi)
#define SEAM(k) do { if (IN(k) && IN((k) + 1)) xcd_barrier(bar); } while (0)
    if (IN(0)) { ph_adaln(F); } SEAM(0);
    if (IN(1)) { ph_norm_mod(F, F_x, F_ffn1_norm, 0 * D, 1 * D, F_XN); } SEAM(1);
    if (IN(2)) { EpiSwiglu E{F_ACT}; naive_gemm<16, 2>(F, F_XN, F_XN, D, D, F_ffn1_wg, F_ffn1_wu, DFF, DFF, E); } SEAM(2);
    if (IN(3)) { EpiResid E{F.H, F_x, F_MOD, 2 * D, 0.5f}; naive_gemm<8, 1>(F, F_ACT, F_ACT, DFF, DFF, F_ffn1_wd, F_ffn1_wd, D, D, E); } SEAM(3);
    if (IN(4)) { ph_norm_mod(F, F.H, F_mix_norm, 3 * D, 4 * D, F_XN); } SEAM(4);
    if (IN(5)) { EpiZ E{F_ZA, F_ZB, F_ZG}; naive_gemm<16, 1>(F, F_XN, F_XN, D, D, F_w_in, F_w_in, IN_COLS, IN_COLS, E); } SEAM(5);
    if (IN(6)) { ph_mla_prep(F); ph_diff_prep(F); } SEAM(6);
    if (IN(7)) { ph_attention(F); } SEAM(7);
    if (IN(8)) { ph_subln(F); } SEAM(8);
    if (IN(9)) { EpiMerge E{F_MRG, F_ZG}; naive_gemm<16, 2>(F, F_OM, F_OD, 512, 512, F_mla_wo, F_diff_wo, D, D, E); } SEAM(9);
    if (IN(10)) { EpiResid E{F.H, F.H, F_MOD, 5 * D, 1.0f}; naive_gemm<16, 1>(F, F_MRG, F_MRG, D, D, F_w_out, F_w_out, D, D, E); } SEAM(10);
    if (IN(11)) { ph_norm_mod(F, F.H, F_ffn2_norm, 6 * D, 7 * D, F_XN); } SEAM(11);
    if (IN(12)) { EpiSwiglu E{F_ACT}; naive_gemm<16, 2>(F, F_XN, F_XN, D, D, F_ffn2_wg, F_ffn2_wu, DFF, DFF, E); } SEAM(12);
    if (IN(13)) { EpiResid E{F.H, F.H, F_MOD, 8 * D, 0.5f}; naive_gemm<8, 1>(F, F_ACT, F_ACT, DFF, DFF, F_ffn2_wd, F_ffn2_wd, D, D, E); } SEAM(13);
    if (IN(14)) { ph_final_norm(F); }
#undef IN
#undef SEAM
}

#ifndef MK_ONE_LAUNCH
#define MK_ONE_LAUNCH 1
#endif

extern "C" void kernel_launch(void* const* d_in, const int* in_sizes, int n_in, void* d_out, int out_size, void* d_ws, size_t ws_size, hipStream_t stream) {
    static int grid = 0;
    if (grid == 0) {
        if (n_in != 32 || in_sizes[0] != M * D || out_size != M * D || ws_size < WS_END) {
            fprintf(stderr, "kernel_launch: unexpected shapes: n_in %d in0 %d out %d ws %zu (need %zu)\n", n_in, n_in > 0 ? in_sizes[0] : -1, out_size, ws_size, (size_t)WS_END); grid = -1; return; }
        int dev = 0, cus = 0, per_cu = 0;
        if (hipGetDevice(&dev) != hipSuccess || hipDeviceGetAttribute(&cus, hipDeviceAttributeMultiprocessorCount, dev) != hipSuccess) { grid = -1; return; }
        if (hipFuncSetAttribute((const void*)mk_fwd, hipFuncAttributeMaxDynamicSharedMemorySize, LDS_BYTES) != hipSuccess) { fprintf(stderr, "kernel_launch: hipFuncSetAttribute failed\n"); grid = -1; return; }
        if (hipOccupancyMaxActiveBlocksPerMultiprocessor(&per_cu, (const void*)mk_fwd, NTHR, LDS_BYTES) != hipSuccess || per_cu < 1) {
            fprintf(stderr, "kernel_launch: occupancy query says %d blocks per CU\n", per_cu); per_cu = 1; }
        (void)hipGetLastError();
        grid = cus;
    }
    if (grid < 0) return;
    if (hipMemsetAsync((char*)d_ws + WS_CTL, 0, CTL_ZERO_BYTES, stream) != hipSuccess) { fprintf(stderr, "kernel_launch: memset failed\n"); return; }
    Args a{};
    for (int i = 0; i < 32; ++i) a.in[i] = d_in[i];
    a.out = (float*)d_out; a.ws = (unsigned char*)d_ws;
#if MK_ONE_LAUNCH
    a.ph_lo = 0; a.ph_hi = NPH;
    hipLaunchKernelGGL(mk_fwd, dim3(grid), dim3(NTHR), LDS_BYTES, stream, a);
#else
    for (int p = 0; p < NPH; ++p) { a.ph_lo = p; a.ph_hi = p + 1; hipLaunchKernelGGL(mk_fwd, dim3(grid), dim3(NTHR), LDS_BYTES, stream, a); }
#endif
    const hipError_t le = hipPeekAtLastError();
    if (le != hipSuccess) fprintf(stderr, "kernel_launch: launch failed: %s\n", hipGetErrorName(le));
}
```

```cpp
#include <hip/hip_runtime.h>
#include <cstdio>
#include <cstdint>

constexpr int BATCH = 8, SEQ = 2048, D = 1024, M = BATCH * SEQ, DFF = 2816, ADA = 9 * D;
constexpr int QLORA = 384, KVLORA = 256, ROPE_A = 32, MLA_H = 8, MLA_QK = 96, MLA_NOPE = 64, MLA_V = 64;
constexpr int DF_H = 4, DF_D = 64, DF_V = 128, ROT = 16;
constexpr int IN_COLS = 4256;
constexpr int ZA_LD = 768, ZB_LD = 1536, ZG_LD = 2048;
constexpr float EPS = 1e-6f;
constexpr float LOG2E = 1.4426950408889634f;
constexpr float C2_MLA = 0.10206207261596577f * LOG2E;
constexpr float C2_DF = 0.125f * LOG2E;
constexpr float LAMBDA_INIT = 0.2f;
constexpr int NWAVES = 8, NTHR = 512;

constexpr size_t MiB = 1u << 20;
constexpr size_t WS_CTL = 0, CTL_ZERO_BYTES = 1 * MiB;
constexpr size_t WS_MOD = 1 * MiB;
constexpr size_t WS_WUP = 2 * MiB;
constexpr size_t WS_WDN = 13 * MiB;
constexpr size_t WS_VM = 2 * MiB;
constexpr size_t WS_WIN = 18 * MiB + 512 * 1024;
constexpr size_t WS_WO = 27 * MiB;
constexpr size_t WS_WOUT = 29 * MiB;
constexpr size_t WS_WUQ = 31 * MiB;
constexpr size_t WS_WUKV = 32 * MiB;
constexpr size_t WS_XN = 33 * MiB;
constexpr size_t WS_OMD = 33 * MiB;
constexpr size_t WS_BIG = 65 * MiB;
constexpr size_t WS_ACT = WS_BIG;
constexpr size_t WS_ZG = WS_BIG;
constexpr size_t WS_ZB = WS_BIG + 64 * MiB;
constexpr size_t WS_ZA = WS_BIG + 112 * MiB;
constexpr size_t WS_QM = WS_BIG + 136 * MiB;
constexpr size_t WS_KM = WS_BIG + 160 * MiB;
constexpr size_t WS_MRG = WS_QM;
constexpr size_t WS_END = WS_BIG + 184 * MiB;
constexpr int CW_BAR = 4096;

constexpr int LDS_BYTES = 147456, RING_BYTES = 131072, LDSCTL_OFF = RING_BYTES, MISC_OFF = LDSCTL_OFF + 320;

#define GAS __attribute__((address_space(1)))
#define LAS __attribute__((address_space(3)))
typedef unsigned short bf16;
typedef float f32x4 __attribute__((ext_vector_type(4)));

__device__ __forceinline__ float bf2f(bf16 v) { return __uint_as_float(((unsigned)v) << 16); }
__device__ __forceinline__ bf16 f2bf(float f) { unsigned u = __float_as_uint(f); return (bf16)((u + 0x7fffu + ((u >> 16) & 1u)) >> 16); }
__device__ __forceinline__ float silu_f(float v) { return v / (1.f + __expf(-v)); }
__device__ __forceinline__ float sigmoid_f(float v) { return 1.f / (1.f + __expf(-v)); }
__device__ __forceinline__ float wave_sum(float v) {
#pragma unroll
    for (int o = 1; o < 64; o <<= 1) v += __shfl_xor(v, o);
    return v;
}
__device__ __forceinline__ void sincos_red(float ang, float& sn, float& cs) {
    double t = (double)ang * 0.15915494309189535;
    t -= __builtin_rint(t);
    const float r = (float)t;
    sn = __builtin_amdgcn_sinf(r); cs = __builtin_amdgcn_cosf(r);
}

#define XB_TMO      128
#define XB_XCNT(j)  (256  + 64 * (j))
#define XB_XSUB(j)  (1280 + 64 * (j))
#define XB_XGEN(j)  (2304 + 64 * (j))
#define XB_TOP      3328
#define XB_TOPGEN   3392
#define XCD_BAR_WORDS 3456
#define XB_SPIN_CAP (1u << 24)
__device__ __forceinline__ unsigned xb_ld(unsigned* p)              { return __hip_atomic_load(p, __ATOMIC_RELAXED, __HIP_MEMORY_SCOPE_AGENT); }
__device__ __forceinline__ unsigned xb_add(unsigned* p, unsigned v) { return __hip_atomic_fetch_add(p, v, __ATOMIC_RELAXED, __HIP_MEMORY_SCOPE_AGENT); }
__device__ __forceinline__ unsigned xb_xcc_id() { return (unsigned)__builtin_amdgcn_s_getreg((3 << 11) | 20) & 0xFu; }
#define XB_SPIN(cond, bar) do { unsigned _sp = 0; while (cond) { __builtin_amdgcn_s_sleep(1); \
    if ((++_sp & 255u) == 0u) { if (xb_ld(&(bar)[XB_TMO])) break; if (_sp > XB_SPIN_CAP) { atomicAdd(&(bar)[XB_TMO], 1u); break; } } } } while (0)
struct XcdBarrier { unsigned* bar; unsigned x; volatile LAS unsigned* st; };
__device__ __forceinline__ XcdBarrier xcd_barrier_post(unsigned* bar, volatile LAS unsigned* st) {
    XcdBarrier b; b.bar = bar; b.x = xb_xcc_id(); b.st = st;
    if (threadIdx.x == 0) (void)xb_add(&bar[XB_XCNT(b.x)], 1u);
    return b;
}
__device__ __forceinline__ void xcd_barrier_complete(unsigned* bar, unsigned x, unsigned& nloc, unsigned& nx) {
    const unsigned G = gridDim.x * gridDim.y * gridDim.z;
    unsigned sum, cnt, mine, sp = 0u;
    for (;;) {
        sum = 0u; cnt = 0u; mine = 0u;
#pragma unroll
        for (unsigned j = 0; j < 16; ++j) { const unsigned c = xb_ld(&bar[XB_XCNT(j)]); sum += c; cnt += (c > 0u) ? 1u : 0u; mine = (j == x) ? c : mine; }
        if (sum == G) break;
        __builtin_amdgcn_s_sleep(1);
        if ((++sp & 255u) == 0u) { if (xb_ld(&bar[XB_TMO])) break; if (sp > XB_SPIN_CAP) { atomicAdd(&bar[XB_TMO], 1u); break; } }
    }
    nloc = mine > 0u ? mine : 1u; nx = cnt > 0u ? cnt : 1u;
}
__device__ __forceinline__ void xcd_barrier(const XcdBarrier& b) {
    asm volatile("s_waitcnt vmcnt(0)" ::: "memory");
    __syncthreads();
    if (threadIdx.x == 0) {
        unsigned* bar = b.bar;
        __builtin_amdgcn_s_waitcnt(0);
        unsigned nloc = b.st[0], nx = b.st[1];
        if (nloc == 0u) { xcd_barrier_complete(bar, b.x, nloc, nx); b.st[0] = nloc; b.st[1] = nx; }
        const unsigned old = xb_add(&bar[XB_XSUB(b.x)], 1u);
        const unsigned gen = old / nloc;
        if (old + 1u == (gen + 1u) * nloc) {
            __builtin_amdgcn_fence(__ATOMIC_RELEASE, "agent");
            asm volatile("s_waitcnt vmcnt(0)" ::: "memory");
            const unsigned og = xb_add(&bar[XB_TOP], 1u);
            const unsigned tg = og / nx;
            if (og + 1u == (tg + 1u) * nx) xb_add(&bar[XB_TOPGEN], 1u);
            else XB_SPIN(xb_ld(&bar[XB_TOPGEN]) == tg, bar);
            __builtin_amdgcn_fence(__ATOMIC_ACQUIRE, "agent");
            xb_add(&bar[XB_XGEN(b.x)], 1u);
            asm volatile("s_waitcnt vmcnt(0)" ::: "memory");
        } else {
            XB_SPIN(xb_ld(&bar[XB_XGEN(b.x)]) == gen, bar);
            __builtin_amdgcn_fence(__ATOMIC_ACQUIRE, "agent");
            asm volatile("s_waitcnt vmcnt(0)" ::: "memory");
        }
    }
    __syncthreads();
}

namespace pg8 {
#define PG8_LAS __attribute__((address_space(3)))
typedef unsigned short bf16_t;
typedef short bf16x8 __attribute__((ext_vector_type(8)));
typedef float f32x4 __attribute__((ext_vector_type(4)));
typedef unsigned u32x4 __attribute__((ext_vector_type(4)));
constexpr int BM = 256, BK = 64, HALF = 128, HTB = HALF * BK * 2  , STAGE_BYTES = 8 * HTB, NXCD = 8, WGM = 8;

__host__ __device__ __forceinline__ int lds_byte(int r, int c) { const int st = (r >> 4) * 2 + (c >> 5), rr = r & 15, cc = c & 31, ob = rr * 64 + cc * 2; return st * 1024 + (ob ^ (((ob >> 9) & 1) << 5)); }
__host__ __device__ __forceinline__ void stage_rc(int b, int& R, int& C) { const int st = b / 1024, sb = b % 1024, swz = sb ^ (((sb >> 9) & 1) << 5); R = (st >> 1) * 16 + swz / 64; C = (st & 1) * 32 + (swz % 64) / 2; }
__host__ __device__ __forceinline__ int perm32(int rho) { const int n = rho >> 4, i = rho & 15; return 8 * (i >> 2) + 4 * n + (i & 3); }

struct Unit { int pm, pn; };
struct Gemm { const bf16_t* A; const bf16_t* Bt; int M, N, K, lda, ldb; };

struct StaticOrder {
    int nM, nN, nwg, G, c;
    __host__ __device__ void init(int M, int N, int G_, int c_) { nM = M / BM; nN = N / BM; nwg = nM * nN; G = G_; c = c_; }
    __host__ __device__ bool next(int i, Unit& u) const {
        const long L = (long)i * G + c; if (L >= nwg) return false;
        int wgid = (int)L; { const int q = nwg / NXCD, r = nwg % NXCD, xcd = wgid % NXCD, off = wgid / NXCD; wgid = (xcd < r ? xcd * (q + 1) : r * (q + 1) + (xcd - r) * q) + off; }
        const int nig = WGM * nN, gid = wgid / nig, fm = gid * WGM, gsz = (nM - fm) < WGM ? (nM - fm) : WGM;
        u.pm = fm + ((wgid % nig) % gsz); u.pn = (wgid % nig) / gsz; return true;
    }
    __device__ __forceinline__ void a_ready(const Unit&) const {}
    __device__ __forceinline__ void done(const Unit&) const {}
};
__device__ __forceinline__ unsigned cvt_pk_bf16(float lo, float hi) { unsigned r; asm volatile("v_cvt_pk_bf16_f32 %0, %1, %2" : "=v"(r) : "v"(lo), "v"(hi)); return r; }
typedef float f32x2 __attribute__((ext_vector_type(2)));

__device__ __forceinline__ float fast_sigmoid(float v) { return __builtin_amdgcn_rcpf(1.0f + __builtin_amdgcn_exp2f(-1.4426950408889634f * v)); }
struct EpiSwiglu {
    static constexpr bool PERM = true, AFTER_DRAIN = false;
    bf16_t* O; int ldc;
    __device__ __forceinline__ void operator()(const f32x4 (&acc)[2][2][4][2], const Unit& u, int wr, int wc, int fr, int fq) const {
        const int row0 = u.pm * BM + wr * 64 + fr, col0 = u.pn * HALF + wc * 32 + 8 * fq;
#pragma unroll
        for (int ai = 0; ai < 2; ++ai)
#pragma unroll
            for (int m = 0; m < 4; ++m) { bf16_t* rowp = O + (size_t)(row0 + ai * HALF + m * 16) * ldc + col0;
                float v[8];
#pragma unroll
                for (int n = 0; n < 2; ++n)
#pragma unroll
                    for (int j = 0; j < 4; ++j) { const float g = acc[ai][0][m][n][j], up = acc[ai][1][m][n][j]; v[4 * n + j] = g * fast_sigmoid(g) * up; }
                u32x4 w; w.x = cvt_pk_bf16(v[0], v[1]); w.y = cvt_pk_bf16(v[2], v[3]); w.z = cvt_pk_bf16(v[4], v[5]); w.w = cvt_pk_bf16(v[6], v[7]);
                *(u32x4*)rowp = w; }
    }
};
struct EpiResid {
    static constexpr bool PERM = false, AFTER_DRAIN = false;
    const float* base; float* out; const float* gt; int gstride; float scale;
    __device__ __forceinline__ void operator()(const f32x4 (&acc)[2][2][4][2], const Unit& u, int wr, int wc, int fr, int fq) const {
        const int row0 = u.pm * BM + wr * 64 + fr, col0 = u.pn * BM + wc * 32 + 4 * fq;
        const float* gp = gt + (size_t)(u.pm >> 3) * gstride + col0;
        f32x4 gv[2][2];
#pragma unroll
        for (int bj = 0; bj < 2; ++bj)
#pragma unroll
            for (int n = 0; n < 2; ++n) gv[bj][n] = *(const f32x4*)(gp + bj * HALF + n * 16) * scale;
#pragma unroll
        for (int ai = 0; ai < 2; ++ai)
#pragma unroll
            for (int m = 0; m < 4; ++m) { const size_t off = (size_t)(row0 + ai * HALF + m * 16) * 1024 + col0;
#pragma unroll
                for (int bj = 0; bj < 2; ++bj)
#pragma unroll
                    for (int n = 0; n < 2; ++n) { const f32x4 bs = *(const f32x4*)(base + off + bj * HALF + n * 16);
                        *(f32x4*)(out + off + bj * HALF + n * 16) = bs + gv[bj][n] * acc[ai][bj][m][n]; } }
    }
};
struct EpiZ {
    static constexpr bool PERM = true, AFTER_DRAIN = false;
    bf16_t *ZA, *ZB, *ZG;
    __device__ __forceinline__ void operator()(const f32x4 (&acc)[2][2][4][2], const Unit& u, int wr, int wc, int fr, int fq) const {
        bf16_t* base; int ldc, ct;
        if (u.pn < 3) { base = ZA; ldc = 768; ct = u.pn; } else if (u.pn < 9) { base = ZB; ldc = 1536; ct = u.pn - 3; } else { base = ZG; ldc = 2048; ct = u.pn - 9; }
        const int row0 = u.pm * BM + wr * 64 + fr, col0 = ct * BM + wc * 32 + 8 * fq;
#pragma unroll
        for (int ai = 0; ai < 2; ++ai)
#pragma unroll
            for (int m = 0; m < 4; ++m) { bf16_t* rowp = base + (size_t)(row0 + ai * HALF + m * 16) * ldc + col0;
#pragma unroll
                for (int bj = 0; bj < 2; ++bj) { const f32x4 v0 = acc[ai][bj][m][0], v1 = acc[ai][bj][m][1];
                    u32x4 w; w.x = cvt_pk_bf16(v0[0], v0[1]); w.y = cvt_pk_bf16(v0[2], v0[3]); w.z = cvt_pk_bf16(v1[0], v1[1]); w.w = cvt_pk_bf16(v1[2], v1[3]);
                    *(u32x4*)(rowp + bj * HALF) = w; } }
    }
};
template <int PASS> struct EpiGate {
    static constexpr bool PERM = true, AFTER_DRAIN = false;
    bf16_t* O; const bf16_t* ZG;
    __device__ __forceinline__ void operator()(const f32x4 (&acc)[2][2][4][2], const Unit& u, int wr, int wc, int fr, int fq) const {
        const int row0 = u.pm * BM + wr * 64 + fr, col0 = u.pn * BM + wc * 32 + 8 * fq;
#pragma unroll
        for (int ai = 0; ai < 2; ++ai)
#pragma unroll
            for (int m = 0; m < 4; ++m) { const size_t r = (size_t)(row0 + ai * HALF + m * 16);
#pragma unroll
                for (int bj = 0; bj < 2; ++bj) {
                    const u32x4 gl = *(const u32x4*)(ZG + r * 2048 + PASS * 1024 + col0 + bj * HALF);
                    u32x4 prev = (u32x4){0u, 0u, 0u, 0u}; if (PASS == 1) prev = *(const u32x4*)(O + r * 1024 + col0 + bj * HALF);
                    float v[8];
#pragma unroll
                    for (int q = 0; q < 4; ++q) { const unsigned gw = gl[q], pw = prev[q];
                        const float g0 = __uint_as_float(gw << 16), g1 = __uint_as_float(gw & 0xffff0000u);
                        const float p0 = __uint_as_float(pw << 16), p1 = __uint_as_float(pw & 0xffff0000u);
                        const float a0 = acc[ai][bj][m][q >> 1][(q & 1) * 2], a1 = acc[ai][bj][m][q >> 1][(q & 1) * 2 + 1];
                        v[2 * q] = p0 + fast_sigmoid(g0) * a0; v[2 * q + 1] = p1 + fast_sigmoid(g1) * a1; }
                    u32x4 w; w.x = cvt_pk_bf16(v[0], v[1]); w.y = cvt_pk_bf16(v[2], v[3]); w.z = cvt_pk_bf16(v[4], v[5]); w.w = cvt_pk_bf16(v[6], v[7]);
                    *(u32x4*)(O + r * 1024 + col0 + bj * HALF) = w; } }
    }
};

template <class Epi, class Sched, bool ALIGN_EPI = false, bool SP2 = false>
__device__ __forceinline__ void gemm_phase(PG8_LAS unsigned char* lds, const Gemm g, const Sched& S, const Epi& E) {
    const int tid = threadIdx.x, wid = __builtin_amdgcn_readfirstlane(tid >> 6), lane = tid & 63, wr = wid >> 2, wc = wid & 3, fr = lane & 15, fq = lane >> 4;
    const int K = g.K, nt = K / BK;
    unsigned voffA[2], voffB[2];
#pragma unroll
    for (int i = 0; i < 2; ++i) { int R, C; stage_rc(tid * 16 + i * 8192, R, C); const int Rb = Epi::PERM ? ((R & ~31) + perm32(R & 31)) : R;
        voffA[i] = (unsigned)(R * g.lda + C) * 2u; voffB[i] = (unsigned)(Rb * g.ldb + C) * 2u; }
    const size_t kstep = (size_t)(BK * 2);
    const size_t hstepA = (size_t)HALF * g.lda * 2, hstepB = (size_t)HALF * g.ldb * 2;
    const size_t tstepA = 2 * hstepA, tstepB = 2 * hstepB;
    const unsigned ldsw = (unsigned)wid * 1024u;
    const int aoff = lds_byte(wr * 64 + fr, fq * 8), boff = lds_byte(wc * 32 + fr, fq * 8);
#define PG8_SA(b, h) (((b) * 2 + (h)) * HTB)
#define PG8_SB(b, h) ((4 + (b) * 2 + (h)) * HTB)
#define PG8_STAGE(bufoff, gbase, voff) do { _Pragma("unroll") for (int _i = 0; _i < 2; ++_i) \
        __builtin_amdgcn_global_load_lds((const unsigned*)((const char*)(gbase) + (voff)[_i]), (PG8_LAS unsigned*)(lds + (bufoff) + ldsw + _i * 8192), 16, 0, 0); } while (0)
#define PG8_LDA(dst, b, h) do { _Pragma("unroll") for (int m = 0; m < 4; ++m) _Pragma("unroll") for (int k = 0; k < 2; ++k) dst[m][k] = *(const PG8_LAS bf16x8*)(lds + PG8_SA(b, h) + aoff + m * 2048 + k * 1024); } while (0)
#define PG8_LDB(dst, b, h) do { _Pragma("unroll") for (int n = 0; n < 2; ++n) _Pragma("unroll") for (int k = 0; k < 2; ++k) dst[n][k] = *(const PG8_LAS bf16x8*)(lds + PG8_SB(b, h) + boff + n * 2048 + k * 1024); } while (0)
#define PG8_MMA(ai, bj, At, Bt) do { __builtin_amdgcn_s_setprio(1); _Pragma("unroll") for (int m = 0; m < 4; ++m) _Pragma("unroll") for (int n = 0; n < 2; ++n) _Pragma("unroll") for (int k = 0; k < 2; ++k) \
        acc[ai][bj][m][n] = __builtin_amdgcn_mfma_f32_16x16x32_bf16(Bt[n][k], At[m][k], acc[ai][bj][m][n], 0, 0, 0); __builtin_amdgcn_s_setprio(0); } while (0)
#define PG8_WAIT_V(n) asm volatile("s_waitcnt vmcnt(" #n ")" ::: "memory")
#define PG8_WAIT_L(n) asm volatile("s_waitcnt lgkmcnt(" #n ")" ::: "memory")
#define PG8_BAR __builtin_amdgcn_s_barrier()
#define PG8_SCHED __builtin_amdgcn_sched_barrier(0)
    Unit cur, nxt; int ui = 0;
    if (!S.next(0, cur)) return;
    f32x4 acc[2][2][4][2];
#pragma unroll
    for (int a = 0; a < 2; ++a)
#pragma unroll
        for (int b = 0; b < 2; ++b)
#pragma unroll
            for (int m = 0; m < 4; ++m)
#pragma unroll
                for (int n = 0; n < 2; ++n) acc[a][b][m][n] = (f32x4){0.f, 0.f, 0.f, 0.f};
    bf16x8 At[4][2], B0[2][2], B1[2][2];
    const char* cA = (const char*)g.A + (size_t)cur.pm * tstepA; const char* cB = (const char*)g.Bt + (size_t)cur.pn * tstepB;
    S.a_ready(cur);
    if constexpr (SP2) {
        PG8_STAGE(PG8_SB(0, 0), cB, voffB); PG8_STAGE(PG8_SB(0, 1), cB + hstepB, voffB); PG8_STAGE(PG8_SA(0, 0), cA, voffA); PG8_STAGE(PG8_SA(0, 1), cA + hstepA, voffA);
        if (wr == 1) PG8_BAR;
        PG8_WAIT_V(2); PG8_BAR;
        PG8_STAGE(PG8_SB(1, 0), cB + kstep, voffB); PG8_STAGE(PG8_SA(1, 0), cA + kstep, voffA); PG8_STAGE(PG8_SB(1, 1), cB + hstepB + kstep, voffB);
        PG8_WAIT_V(6); PG8_BAR;
    } else {
        PG8_STAGE(PG8_SB(0, 0), cB, voffB); PG8_STAGE(PG8_SA(0, 0), cA, voffA); PG8_STAGE(PG8_SB(0, 1), cB + hstepB, voffB); PG8_STAGE(PG8_SA(0, 1), cA + hstepA, voffA);
        if (wr == 1) PG8_BAR;
        PG8_WAIT_V(4); PG8_BAR;
        PG8_STAGE(PG8_SB(1, 0), cB + kstep, voffB); PG8_STAGE(PG8_SA(1, 0), cA + kstep, voffA); PG8_STAGE(PG8_SB(1, 1), cB + hstepB + kstep, voffB);
        PG8_WAIT_V(6); PG8_BAR;
    }
    for (;;) {
        const bool has_next = S.next(ui + 1, nxt);
        const char* nA = has_next ? (const char*)g.A + (size_t)nxt.pm * tstepA : cA; const char* nB = has_next ? (const char*)g.Bt + (size_t)nxt.pn * tstepB : cB;
        for (int t = 0; t < nt; t += 2) {
            const bool last = (t == nt - 2);
            const char* a1 = cA + (size_t)(t + 1) * kstep;
            const char* a2 = last ? nA : cA + (size_t)(t + 2) * kstep; const char* b2 = last ? nB : cB + (size_t)(t + 2) * kstep;
            const char* a3 = a2 + kstep; const char* b3 = b2 + kstep;
            if (last && has_next) S.a_ready(nxt);
            if constexpr (SP2) {
            PG8_LDB(B0, 0, 0); PG8_LDB(B1, 0, 1); PG8_SCHED; PG8_LDA(At, 0, 0); PG8_STAGE(PG8_SA(1, 1), a1 + hstepA, voffA);
            PG8_WAIT_V(8); PG8_WAIT_L(0); PG8_BAR; PG8_MMA(0, 0, At, B0); PG8_MMA(0, 1, At, B1); PG8_BAR; PG8_SCHED;
            PG8_LDA(At, 0, 1); PG8_STAGE(PG8_SB(0, 0), b2, voffB); PG8_STAGE(PG8_SB(0, 1), b2 + hstepB, voffB); PG8_STAGE(PG8_SA(0, 0), a2, voffA);
            PG8_WAIT_V(8); PG8_WAIT_L(0); PG8_BAR; PG8_MMA(1, 0, At, B0); PG8_MMA(1, 1, At, B1); PG8_BAR; PG8_SCHED;
            PG8_LDB(B0, 1, 0); PG8_LDB(B1, 1, 1); PG8_SCHED; PG8_LDA(At, 1, 0); PG8_STAGE(PG8_SA(0, 1), a2 + hstepA, voffA);
            PG8_WAIT_V(8); PG8_WAIT_L(0); PG8_BAR; PG8_MMA(0, 0, At, B0); PG8_MMA(0, 1, At, B1); PG8_BAR; PG8_SCHED;
            PG8_LDA(At, 1, 1); PG8_STAGE(PG8_SB(1, 0), b3, voffB); PG8_STAGE(PG8_SB(1, 1), b3 + hstepB, voffB); PG8_STAGE(PG8_SA(1, 0), a3, voffA);
            PG8_WAIT_V(8); PG8_WAIT_L(0); PG8_BAR; PG8_MMA(1, 0, At, B0); PG8_MMA(1, 1, At, B1); PG8_BAR; PG8_SCHED;
            } else {
            PG8_LDB(B0, 0, 0); PG8_SCHED; PG8_LDA(At, 0, 0); PG8_STAGE(PG8_SA(1, 1), a1 + hstepA, voffA);
            PG8_WAIT_L(8); PG8_BAR; PG8_WAIT_L(0); PG8_MMA(0, 0, At, B0); PG8_BAR; PG8_SCHED;
            PG8_LDB(B1, 0, 1); PG8_STAGE(PG8_SB(0, 0), b2, voffB);
            PG8_BAR; PG8_WAIT_L(0); PG8_MMA(0, 1, At, B1); PG8_BAR;
            PG8_LDA(At, 0, 1); PG8_STAGE(PG8_SA(0, 0), a2, voffA);
            PG8_BAR; PG8_WAIT_L(0); PG8_MMA(1, 0, At, B0); PG8_BAR; PG8_SCHED;
            PG8_STAGE(PG8_SB(0, 1), b2 + hstepB, voffB);
            PG8_WAIT_V(6); PG8_BAR; PG8_MMA(1, 1, At, B1); PG8_BAR;
            PG8_LDB(B0, 1, 0); PG8_SCHED; PG8_LDA(At, 1, 0); PG8_STAGE(PG8_SA(0, 1), a2 + hstepA, voffA);
            PG8_WAIT_L(8); PG8_BAR; PG8_WAIT_L(0); PG8_MMA(0, 0, At, B0); PG8_BAR; PG8_SCHED;
            PG8_LDB(B1, 1, 1); PG8_STAGE(PG8_SB(1, 0), b3, voffB);
            PG8_BAR; PG8_WAIT_L(0); PG8_MMA(0, 1, At, B1); PG8_BAR;
            PG8_LDA(At, 1, 1); PG8_STAGE(PG8_SA(1, 0), a3, voffA);
            PG8_BAR; PG8_WAIT_L(0); PG8_MMA(1, 0, At, B0); PG8_BAR; PG8_SCHED;
            PG8_STAGE(PG8_SB(1, 1), b3 + hstepB, voffB);
            PG8_WAIT_V(6); PG8_BAR; PG8_MMA(1, 1, At, B1); PG8_BAR;
            }
        }
        if constexpr (ALIGN_EPI) { if (wr == 0) PG8_BAR; }
        if constexpr (!Epi::AFTER_DRAIN) { E(acc, cur, wr, wc, fr, fq); S.done(cur); }
        if (!has_next) break;
#pragma unroll
        for (int a = 0; a < 2; ++a)
#pragma unroll
            for (int b = 0; b < 2; ++b)
#pragma unroll
                for (int m = 0; m < 4; ++m)
#pragma unroll
                    for (int n = 0; n < 2; ++n) acc[a][b][m][n] = (f32x4){0.f, 0.f, 0.f, 0.f};
        cur = nxt; cA = nA; cB = nB; ++ui;
        if constexpr (ALIGN_EPI) { if (wr == 1) PG8_BAR; }
    }
    PG8_WAIT_V(0);
    if constexpr (!ALIGN_EPI) { if (wr == 0) PG8_BAR; }
    PG8_BAR;
    if constexpr (Epi::AFTER_DRAIN) { E.fused(acc, cur, wr, wc, fr, fq, lds, wid, lane); S.done(cur); }
#undef PG8_SA
#undef PG8_SB
#undef PG8_STAGE
#undef PG8_LDA
#undef PG8_LDB
#undef PG8_MMA
#undef PG8_WAIT_V
#undef PG8_WAIT_L
#undef PG8_BAR
#undef PG8_SCHED
}
}
struct Args { const void* in[32]; float* out; unsigned char* ws; int ph_lo, ph_hi; };

struct Frame {
    LAS unsigned char* lds;
    int tid, lane, wave, G, bid;
    const void* const* in;
    unsigned char* ws; float* H;
};
#define FIN(i) ((const float*)F.in[i])
#define F_x FIN(0)
#define F_c FIN(1)
#define F_pos ((const int*)F.in[2])
#define F_w_ada FIN(3)
#define F_b_ada FIN(4)
#define F_ffn1_norm FIN(5)
#define F_ffn1_wg FIN(6)
#define F_ffn1_wu FIN(7)
#define F_ffn1_wd FIN(8)
#define F_mix_norm FIN(9)
#define F_w_in FIN(10)
#define F_q_norm FIN(11)
#define F_w_uq FIN(12)
#define F_kv_norm FIN(13)
#define F_w_ukv FIN(14)
#define F_q_gain FIN(15)
#define F_k_gain FIN(16)
#define F_mla_wo FIN(17)
#define F_dq_gain FIN(18)
#define F_dk_gain FIN(19)
#define F_lq1 FIN(20)
#define F_lk1 FIN(21)
#define F_lq2 FIN(22)
#define F_lk2 FIN(23)
#define F_subln FIN(24)
#define F_diff_wo FIN(25)
#define F_w_out FIN(26)
#define F_ffn2_norm FIN(27)
#define F_ffn2_wg FIN(28)
#define F_ffn2_wu FIN(29)
#define F_ffn2_wd FIN(30)
#define F_final_norm FIN(31)
#define F_MOD ((float*)(F.ws + WS_MOD))
#define F_XN ((bf16*)(F.ws + WS_XN))
#define F_ACT ((bf16*)(F.ws + WS_ACT))
#define F_ZA ((bf16*)(F.ws + WS_ZA))
#define F_ZB ((bf16*)(F.ws + WS_ZB))
#define F_ZG ((bf16*)(F.ws + WS_ZG))
#define F_QM ((bf16*)(F.ws + WS_QM))
#define F_KM ((bf16*)(F.ws + WS_KM))
#define F_VM ((bf16*)(F.ws + WS_VM))
#define F_OMD ((bf16*)(F.ws + WS_OMD))
#define F_MRG ((bf16*)(F.ws + WS_MRG))


typedef unsigned v4u __attribute__((ext_vector_type(4)));
__device__ __forceinline__ unsigned pk2(float lo, float hi) { return (unsigned)f2bf(lo) | ((unsigned)f2bf(hi) << 16); }
__device__ __forceinline__ void tr_item(const float* W, int ldw, int k0, int n0, bf16* WT, int ldk, int drow0, int dk0, LAS float* scr, int lane) {
#pragma unroll 8
    for (int i = 0; i < 32; ++i) { const int kk = 2 * i + (lane >> 5); scr[kk * 33 + (lane & 31)] = W[(size_t)(k0 + kk) * ldw + n0 + (lane & 31)]; }
    asm volatile("s_waitcnt lgkmcnt(0)" ::: "memory");
    const int c = lane & 7;
#pragma unroll
    for (int j = 0; j < 4; ++j) { const int n = (lane >> 3) + 8 * j; const LAS float* s = scr + (8 * c) * 33 + n;
        v4u o; o.x = pk2(s[0 * 33], s[1 * 33]); o.y = pk2(s[2 * 33], s[3 * 33]); o.z = pk2(s[4 * 33], s[5 * 33]); o.w = pk2(s[6 * 33], s[7 * 33]);
        *(v4u*)(WT + (size_t)(drow0 + n) * ldk + dk0 + k0 + 8 * c) = o; }
    asm volatile("s_waitcnt lgkmcnt(0)" ::: "memory");
}
constexpr int IT_FFN_GU = (D / 64) * (DFF / 32), IT_FFN_D = (DFF / 64) * (D / 32);
__device__ __forceinline__ void tr_ffn(Frame& F, const float* wg, const float* wu, const float* wd, int gw, int NGW) {
    LAS float* scr = (LAS float*)(F.lds + F.wave * 16384);
    bf16* WUP = (bf16*)(F.ws + WS_WUP); bf16* WDN = (bf16*)(F.ws + WS_WDN);
    for (int it = gw; it < 2 * IT_FFN_GU + IT_FFN_D; it += NGW) {
        if (it < 2 * IT_FFN_GU) { const int up = it >= IT_FFN_GU, r = up ? it - IT_FFN_GU : it, nblk = DFF / 32, kb = r / nblk, nb = r % nblk, n0 = 32 * nb;
            tr_item(up ? wu : wg, DFF, 64 * kb, n0, WUP, D, 256 * (n0 >> 7) + (n0 & 127) + 128 * up, 0, scr, F.lane); }
        else { const int r = it - 2 * IT_FFN_GU, nblk = D / 32, kb = r / nblk, nb = r % nblk;
            tr_item(wd, D, 64 * kb, 32 * nb, WDN, DFF, 32 * nb, 0, scr, F.lane); }
    }
}
constexpr int IT_WIN = (D / 64) * (IN_COLS / 32), IT_WO = (512 / 64) * (D / 32), IT_WOUT = (D / 64) * (D / 32);
__device__ __forceinline__ void tr_misc(Frame& F, int gw, int NGW) {
    LAS float* scr = (LAS float*)(F.lds + F.wave * 16384);
    bf16* WIN = (bf16*)(F.ws + WS_WIN); bf16* WO = (bf16*)(F.ws + WS_WO); bf16* WOUT = (bf16*)(F.ws + WS_WOUT);
    for (int it = gw; it < IT_WIN + 2 * IT_WO + IT_WOUT; it += NGW) {
        int r = it;
        if (r < IT_WIN) { const int nblk = IN_COLS / 32, kb = r / nblk, nb = r % nblk, n0 = 32 * nb;
            tr_item(F_w_in, IN_COLS, 64 * kb, n0, WIN, D, n0 < 672 ? n0 : n0 + 96, 0, scr, F.lane); continue; } r -= IT_WIN;
        if (r < 2 * IT_WO) { const int second = r >= IT_WO, q = second ? r - IT_WO : r, nblk = D / 32, kb = q / nblk, nb = q % nblk;
            tr_item(second ? F_diff_wo : F_mla_wo, D, 64 * kb, 32 * nb, WO, D, 32 * nb, 512 * second, scr, F.lane); continue; } r -= 2 * IT_WO;
        { const int nblk = D / 32, kb = r / nblk, nb = r % nblk; tr_item(F_w_out, D, 64 * kb, 32 * nb, WOUT, D, 32 * nb, 0, scr, F.lane); }
    }
    for (int i = gw * 64 + F.lane; i < 96 * D / 8; i += NGW * 64) *(v4u*)(WIN + (size_t)672 * D + (size_t)i * 8) = (v4u){0u, 0u, 0u, 0u};
}
__device__ __forceinline__ void ph_adaln(Frame& F) {
    LAS float* condL = (LAS float*)F.lds;
    LAS float* red = condL + 8 * 1024;
    for (int i = F.tid; i < 8 * 1024; i += NTHR) condL[i] = silu_f(F_c[i]);
    __syncthreads();
    constexpr int CPB = ADA / 256;
    for (int it = F.bid; it < 256; it += F.G) {
        const int n0 = it * CPB, col = F.tid % CPB, kg = F.tid / CPB;
        float acc[8];
#pragma unroll
        for (int b = 0; b < 8; ++b) acc[b] = 0.f;
        if (kg < 14) for (int k = kg; k < D; k += 14) { const float w = F_w_ada[(size_t)k * ADA + n0 + col];
#pragma unroll
            for (int b = 0; b < 8; ++b) acc[b] += condL[b * 1024 + k] * w; }
        if (kg < 14) {
#pragma unroll
            for (int b = 0; b < 8; ++b) red[(kg * CPB + col) * 8 + b] = acc[b]; }
        __syncthreads();
        if (F.tid < CPB * 8) { const int cc = F.tid / 8, b = F.tid % 8; float s = F_b_ada[n0 + cc];
            for (int g = 0; g < 14; ++g) s += red[(g * CPB + cc) * 8 + b];
            F_MOD[b * ADA + n0 + cc] = s; }
        __syncthreads();
    }
}
__device__ __forceinline__ void ph_norm_mod(Frame& F, const float* src, const float* gain, int sh_off, int sc_off, bf16* dst) {
    const int gw = F.bid * NWAVES + F.wave, NGW = F.G * NWAVES;
    for (int m = gw; m < M; m += NGW) {
        const int b = m / SEQ;
        const f32x4* xr = (const f32x4*)(src + (size_t)m * D) + F.lane;
        f32x4 v[4]; float s = 0.f;
#pragma unroll
        for (int j = 0; j < 4; ++j) { v[j] = xr[64 * j]; s += (v[j].x * v[j].x + v[j].y * v[j].y) + (v[j].z * v[j].z + v[j].w * v[j].w); }
        const float rstd = 1.f / sqrtf(wave_sum(s) * (1.f / D) + EPS);
#pragma unroll
        for (int j = 0; j < 4; ++j) {
            const int c0 = 4 * F.lane + 256 * j;
            const f32x4 g = *(const f32x4*)(gain + c0), sc = *(const f32x4*)(F_MOD + b * ADA + sc_off + c0), sh = *(const f32x4*)(F_MOD + b * ADA + sh_off + c0);
            const f32x4 o = v[j] * rstd * g * (1.f + sc) + sh;
            ushort4 w; w.x = f2bf(o.x); w.y = f2bf(o.y); w.z = f2bf(o.z); w.w = f2bf(o.w);
            *(ushort4*)(dst + (size_t)m * D + c0) = w;
        }
    }
}
__device__ __forceinline__ void ph_final_norm(Frame& F) {
    const int gw = F.bid * NWAVES + F.wave, NGW = F.G * NWAVES;
    for (int m = gw; m < M; m += NGW) {
        f32x4* xr = (f32x4*)(F.H + (size_t)m * D) + F.lane;
        f32x4 v[4]; float s = 0.f;
#pragma unroll
        for (int j = 0; j < 4; ++j) { v[j] = xr[64 * j]; s += (v[j].x * v[j].x + v[j].y * v[j].y) + (v[j].z * v[j].z + v[j].w * v[j].w); }
        const float rstd = 1.f / sqrtf(wave_sum(s) * (1.f / D) + EPS);
#pragma unroll
        for (int j = 0; j < 4; ++j) { const f32x4 g = *(const f32x4*)(F_final_norm + 4 * F.lane + 256 * j); xr[64 * j] = v[j] * rstd * g; }
    }
}

template <int R, int NMAT, class Epi>
__device__ __forceinline__ void naive_gemm(Frame& F, const bf16* A0, const bf16* A1, int lda, int K, const float* W0, const float* W1, int ldw, int N, const Epi& epi) {
    LAS float* L0 = (LAS float*)F.lds;
    const bool sameA = (A1 == A0) || (NMAT == 1);
    LAS float* L1 = sameA ? L0 : L0 + (size_t)K * R;
    for (int rb = F.bid; rb < M / R; rb += F.G) {
        const int r0 = rb * R;
        for (int i = F.tid; i < R * K; i += NTHR) { const int r = i / K, k = i % K; L0[k * R + r] = bf2f(A0[(size_t)(r0 + r) * lda + k]); }
        if (!sameA) for (int i = F.tid; i < R * K; i += NTHR) { const int r = i / K, k = i % K; L1[k * R + r] = bf2f(A1[(size_t)(r0 + r) * lda + k]); }
        __syncthreads();
        for (int n = F.tid; n < N; n += NTHR) {
            float acc0[R], acc1[R];
#pragma unroll
            for (int r = 0; r < R; ++r) { acc0[r] = 0.f; acc1[r] = 0.f; }
#pragma unroll 4
            for (int k = 0; k < K; ++k) {
                const float w0 = W0[(size_t)k * ldw + n];
                float w1 = 0.f; if (NMAT == 2) w1 = W1[(size_t)k * ldw + n];
#pragma unroll
                for (int r4 = 0; r4 < R / 4; ++r4) {
                    const f32x4 a = *(const LAS f32x4*)(L0 + k * R + 4 * r4);
                    acc0[4 * r4 + 0] += a.x * w0; acc0[4 * r4 + 1] += a.y * w0; acc0[4 * r4 + 2] += a.z * w0; acc0[4 * r4 + 3] += a.w * w0;
                    if (NMAT == 2) { const f32x4 a1 = *(const LAS f32x4*)(L1 + k * R + 4 * r4);
                        acc1[4 * r4 + 0] += a1.x * w1; acc1[4 * r4 + 1] += a1.y * w1; acc1[4 * r4 + 2] += a1.z * w1; acc1[4 * r4 + 3] += a1.w * w1; }
                }
            }
#pragma unroll
            for (int r = 0; r < R; ++r) epi(r0 + r, n, acc0[r], acc1[r]);
        }
        __syncthreads();
    }
}

__device__ __forceinline__ void ph_mla_prep(Frame& F) {
    constexpr int R = 16;
    LAS float* A = (LAS float*)F.lds;
    LAS float* SC = A + 384 * R;
    LAS float* OUT = SC + 64;
    for (int rb = F.bid; rb < M / R; rb += F.G) {
        const int r0 = rb * R;
        for (int i = F.tid; i < R * QLORA; i += NTHR) { const int r = i / QLORA, k = i % QLORA; A[k * R + r] = bf2f(F_ZA[(size_t)(r0 + r) * ZA_LD + k]); }
        __syncthreads();
        if (F.tid < R) { float ss = 0.f; for (int k = 0; k < QLORA; ++k) { const float v = A[k * R + F.tid]; ss += v * v; } SC[F.tid] = 1.f / sqrtf(ss * (1.f / QLORA) + EPS); }
        __syncthreads();
        for (int i = F.tid; i < R * QLORA; i += NTHR) { const int r = i % R, k = i / R; A[k * R + r] *= SC[r] * F_q_norm[k]; }
        __syncthreads();
        for (int n = F.tid; n < MLA_H * MLA_QK; n += NTHR) {
            float acc[R];
#pragma unroll
            for (int r = 0; r < R; ++r) acc[r] = 0.f;
#pragma unroll 4
            for (int k = 0; k < QLORA; ++k) { const float w = F_w_uq[(size_t)k * (MLA_H * MLA_QK) + n];
#pragma unroll
                for (int r4 = 0; r4 < R / 4; ++r4) { const f32x4 a = *(const LAS f32x4*)(A + k * R + 4 * r4);
                    acc[4 * r4] += a.x * w; acc[4 * r4 + 1] += a.y * w; acc[4 * r4 + 2] += a.z * w; acc[4 * r4 + 3] += a.w * w; } }
#pragma unroll
            for (int r = 0; r < R; ++r) OUT[r * 1024 + n] = acc[r];
        }
        __syncthreads();
        if (F.tid < R * MLA_H) {
            const int r = F.tid / MLA_H, h = F.tid % MLA_H, row = r0 + r;
            const LAS float* q = OUT + r * 1024 + h * MLA_QK;
            float ss = 0.f; for (int d = 0; d < MLA_QK; ++d) ss += q[d] * q[d];
            const float s = 1.f / sqrtf(ss * (1.f / MLA_QK) + EPS) * C2_MLA;
            bf16* dst = F_QM + (size_t)row * 768 + h * MLA_QK;
            for (int d = 0; d < MLA_NOPE; ++d) dst[d] = f2bf(q[d] * s * F_q_gain[d]);
            const float p = (float)F_pos[row];
            for (int i = 0; i < 16; ++i) {
                const float freq = exp2f(-13.287712379549449f * (float)i * (1.f / 16.f));
                float sn, cs; sincos_red(p * freq, sn, cs);
                const float x1 = q[64 + i] * s * F_q_gain[64 + i], x2 = q[80 + i] * s * F_q_gain[80 + i];
                dst[64 + i] = f2bf(x1 * cs - x2 * sn); dst[80 + i] = f2bf(x2 * cs + x1 * sn);
            }
        }
        __syncthreads();
        for (int i = F.tid; i < R * KVLORA; i += NTHR) { const int r = i / KVLORA, k = i % KVLORA; A[k * R + r] = bf2f(F_ZA[(size_t)(r0 + r) * ZA_LD + QLORA + k]); }
        __syncthreads();
        if (F.tid < R) { float ss = 0.f; for (int k = 0; k < KVLORA; ++k) { const float v = A[k * R + F.tid]; ss += v * v; } SC[F.tid] = 1.f / sqrtf(ss * (1.f / KVLORA) + EPS); }
        __syncthreads();
        for (int i = F.tid; i < R * KVLORA; i += NTHR) { const int r = i % R, k = i / R; A[k * R + r] *= SC[r] * F_kv_norm[k]; }
        __syncthreads();
        for (int n = F.tid; n < 1024; n += NTHR) {
            float acc[R];
#pragma unroll
            for (int r = 0; r < R; ++r) acc[r] = 0.f;
#pragma unroll 4
            for (int k = 0; k < KVLORA; ++k) { const float w = F_w_ukv[(size_t)k * 1024 + n];
#pragma unroll
                for (int r4 = 0; r4 < R / 4; ++r4) { const f32x4 a = *(const LAS f32x4*)(A + k * R + 4 * r4);
                    acc[4 * r4] += a.x * w; acc[4 * r4 + 1] += a.y * w; acc[4 * r4 + 2] += a.z * w; acc[4 * r4 + 3] += a.w * w; } }
#pragma unroll
            for (int r = 0; r < R; ++r) OUT[r * 1024 + n] = acc[r];
        }
        __syncthreads();
        if (F.tid < R * MLA_H) {
            const int r = F.tid / MLA_H, h = F.tid % MLA_H, row = r0 + r;
            const LAS float* kn = OUT + r * 1024 + h * 128;
            const bf16* kr = F_ZA + (size_t)row * ZA_LD + QLORA + KVLORA;
            float ss = 0.f; for (int d = 0; d < 64; ++d) ss += kn[d] * kn[d];
            for (int d = 0; d < 32; ++d) { const float v = bf2f(kr[d]); ss += v * v; }
            const float s = 1.f / sqrtf(ss * (1.f / MLA_QK) + EPS);
            bf16* dk = F_KM + (size_t)row * 768 + h * MLA_QK;
            for (int d = 0; d < 64; ++d) dk[d] = f2bf(kn[d] * s * F_k_gain[d]);
            const float p = (float)F_pos[row];
            for (int i = 0; i < 16; ++i) {
                const float freq = exp2f(-13.287712379549449f * (float)i * (1.f / 16.f));
                float sn, cs; sincos_red(p * freq, sn, cs);
                const float x1 = bf2f(kr[i]) * s * F_k_gain[64 + i], x2 = bf2f(kr[16 + i]) * s * F_k_gain[80 + i];
                dk[64 + i] = f2bf(x1 * cs - x2 * sn); dk[80 + i] = f2bf(x2 * cs + x1 * sn);
            }
            bf16* dv = F_VM + (size_t)row * 512 + h * 64;
            for (int d = 0; d < 64; ++d) dv[d] = f2bf(kn[64 + d]);
        }
        __syncthreads();
    }
}
__device__ __forceinline__ void ph_diff_prep(Frame& F) {
    const int gt = F.bid * NTHR + F.tid, NGT = F.G * NTHR;
    for (int it = gt; it < M * 16; it += NGT) {
        const int row = it >> 4, ch = it & 15;
        bf16* p = F_ZB + (size_t)row * ZB_LD + ch * 64;
        const bool isq = ch < 8;
        const float* gain = isq ? F_dq_gain : F_dk_gain;
        float ss = 0.f;
        for (int d = 0; d < 64; ++d) { const float v = bf2f(p[d]); ss += v * v; }
        const float s = 1.f / sqrtf(ss * (1.f / 64.f) + EPS) * (isq ? C2_DF : 1.f);
        const float ps = (float)F_pos[row];
        float o1[8], o2[8];
#pragma unroll
        for (int i = 0; i < 8; ++i) {
            const float freq = exp2f(-18.931568569324174f * (float)i * (1.f / 8.f));
            float sn, cs; sincos_red(ps * freq, sn, cs);
            const float x1 = bf2f(p[i]) * s * gain[i], x2 = bf2f(p[8 + i]) * s * gain[8 + i];
            o1[i] = x1 * cs - x2 * sn; o2[i] = x2 * cs + x1 * sn;
        }
        for (int d = 16; d < 64; ++d) p[d] = f2bf(bf2f(p[d]) * s * gain[d]);
#pragma unroll
        for (int i = 0; i < 8; ++i) { p[i] = f2bf(o1[i]); p[8 + i] = f2bf(o2[i]); }
    }
}

constexpr int TK = 16;
template <int DQK, int DV>
__device__ __forceinline__ void attn_sweep(Frame& F, const float (&q)[DQK / 4], float (&o)[DV / 4], float& m, float& l, const bf16* Kb, int ldk, const bf16* Vb, int ldv) {
    constexpr int QP = DQK / 4, VP = DV / 4;
    const int part = F.tid & 3;
    LAS float* KL = (LAS float*)F.lds;
    LAS float* VL = KL + TK * DQK;
    for (int t0 = 0; t0 < SEQ; t0 += TK) {
        __syncthreads();
        for (int i = F.tid; i < TK * DQK; i += NTHR) { const int j = i / DQK, d = i % DQK; KL[i] = bf2f(Kb[(size_t)(t0 + j) * ldk + d]); }
        for (int i = F.tid; i < TK * DV; i += NTHR) { const int j = i / DV, d = i % DV; VL[i] = bf2f(Vb[(size_t)(t0 + j) * ldv + d]); }
        __syncthreads();
#pragma unroll 2
        for (int j = 0; j < TK; ++j) {
            float a = 0.f;
#pragma unroll
            for (int d4 = 0; d4 < QP / 4; ++d4) { const f32x4 kv = *(const LAS f32x4*)(KL + j * DQK + part * QP + 4 * d4);
                a += q[4 * d4] * kv.x + q[4 * d4 + 1] * kv.y + q[4 * d4 + 2] * kv.z + q[4 * d4 + 3] * kv.w; }
            a += __shfl_xor(a, 1); a += __shfl_xor(a, 2);
            const float mn = fmaxf(m, a), alpha = exp2f(m - mn), p = exp2f(a - mn);
            l = l * alpha + p; m = mn;
#pragma unroll
            for (int d4 = 0; d4 < VP / 4; ++d4) { const f32x4 vv = *(const LAS f32x4*)(VL + j * DV + part * VP + 4 * d4);
                o[4 * d4] = o[4 * d4] * alpha + p * vv.x; o[4 * d4 + 1] = o[4 * d4 + 1] * alpha + p * vv.y;
                o[4 * d4 + 2] = o[4 * d4 + 2] * alpha + p * vv.z; o[4 * d4 + 3] = o[4 * d4 + 3] * alpha + p * vv.w; }
        }
    }
}
__device__ __forceinline__ void ph_attention(Frame& F) {
    const int part = F.tid & 3, qi = F.tid >> 2;
    for (int u = F.bid; u < 1536; u += F.G) {
        if (u < 1024) {
            const int b = u >> 7, h = (u >> 4) & 7, qc = u & 15;
            const int row = b * SEQ + qc * 128 + qi;
            float q[MLA_QK / 4], o[MLA_V / 4]; float m = -INFINITY, l = 0.f;
#pragma unroll
            for (int d = 0; d < MLA_QK / 4; ++d) q[d] = bf2f(F_QM[(size_t)row * 768 + h * MLA_QK + part * (MLA_QK / 4) + d]);
#pragma unroll
            for (int d = 0; d < MLA_V / 4; ++d) o[d] = 0.f;
            attn_sweep<MLA_QK, MLA_V>(F, q, o, m, l, F_KM + (size_t)b * SEQ * 768 + h * MLA_QK, 768, F_VM + (size_t)b * SEQ * 512 + h * 64, 512);
            const float il = 1.f / l;
#pragma unroll
            for (int d = 0; d < MLA_V / 4; ++d) F_OMD[(size_t)row * 1024 + h * 64 + part * (MLA_V / 4) + d] = f2bf(o[d] * il);
        } else {
            const int v = u - 1024, b = v >> 6, h = (v >> 4) & 3, qc = v & 15;
            const int row = b * SEQ + qc * 128 + qi;
            float lam;
            { float s1 = 0.f, s2 = 0.f; for (int d = 0; d < 64; ++d) { s1 += F_lq1[d] * F_lk1[d]; s2 += F_lq2[d] * F_lk2[d]; } lam = expf(s1) - expf(s2) + LAMBDA_INIT; }
            float q[DF_D / 4], o1[DF_V / 4], o[DF_V / 4];
            const bf16* Zb = F_ZB + (size_t)b * SEQ * ZB_LD;
            { float m = -INFINITY, l = 0.f;
#pragma unroll
              for (int d = 0; d < DF_D / 4; ++d) q[d] = bf2f(F_ZB[(size_t)row * ZB_LD + h * 128 + part * (DF_D / 4) + d]);
#pragma unroll
              for (int d = 0; d < DF_V / 4; ++d) o[d] = 0.f;
              attn_sweep<DF_D, DF_V>(F, q, o, m, l, Zb + 512 + h * 128, ZB_LD, Zb + 1024 + h * 128, ZB_LD);
              const float il = 1.f / l;
#pragma unroll
              for (int d = 0; d < DF_V / 4; ++d) o1[d] = o[d] * il; }
            { float m = -INFINITY, l = 0.f;
#pragma unroll
              for (int d = 0; d < DF_D / 4; ++d) q[d] = bf2f(F_ZB[(size_t)row * ZB_LD + h * 128 + 64 + part * (DF_D / 4) + d]);
#pragma unroll
              for (int d = 0; d < DF_V / 4; ++d) o[d] = 0.f;
              attn_sweep<DF_D, DF_V>(F, q, o, m, l, Zb + 512 + h * 128 + 64, ZB_LD, Zb + 1024 + h * 128, ZB_LD);
              const float il = lam / l;
#pragma unroll
              for (int d = 0; d < DF_V / 4; ++d) F_OMD[(size_t)row * 1024 + 512 + h * 128 + part * (DF_V / 4) + d] = f2bf(o1[d] - o[d] * il); }
        }
    }
}
__device__ __forceinline__ void ph_subln(Frame& F) {
    const int gt = F.bid * NTHR + F.tid, NGT = F.G * NTHR;
    for (int it = gt; it < M * 4; it += NGT) {
        bf16* p = F_OMD + (size_t)(it >> 2) * 1024 + 512 + (it & 3) * 128;
        float ss = 0.f;
        for (int d = 0; d < 128; ++d) { const float v = bf2f(p[d]); ss += v * v; }
        const float s = 1.f / sqrtf(ss * (1.f / 128.f) + EPS) * (1.f - LAMBDA_INIT);
        for (int d = 0; d < 128; ++d) p[d] = f2bf(bf2f(p[d]) * s * F_subln[d]);
    }
}

struct NEpiSwiglu { bf16* ACT; __device__ __forceinline__ void operator()(int row, int col, float g, float u) const { ACT[(size_t)row * DFF + col] = f2bf(silu_f(g) * u); } };
struct NEpiResid { float* H; const float* base; const float* MOD; int gt_off; float scale;
    __device__ __forceinline__ void operator()(int row, int col, float a, float) const { const int b = row / SEQ; H[(size_t)row * D + col] = base[(size_t)row * D + col] + scale * MOD[b * ADA + gt_off + col] * a; } };
struct NEpiZ { bf16 *ZA, *ZB, *ZG;
    __device__ __forceinline__ void operator()(int row, int col, float a, float) const {
        if (col < 672) ZA[(size_t)row * ZA_LD + col] = f2bf(a);
        else if (col < 2208) ZB[(size_t)row * ZB_LD + (col - 672)] = f2bf(a);
        else ZG[(size_t)row * ZG_LD + (col - 2208)] = f2bf(a); } };
struct NEpiMerge { bf16* MRG; const bf16* ZG;
    __device__ __forceinline__ void operator()(int row, int col, float ya, float yb) const {
        const float ga = sigmoid_f(bf2f(ZG[(size_t)row * ZG_LD + col])), gb = sigmoid_f(bf2f(ZG[(size_t)row * ZG_LD + 1024 + col]));
        MRG[(size_t)row * D + col] = f2bf(ga * ya + gb * yb); } };

constexpr int NPH = 15;

__global__ void __launch_bounds__(NTHR, 2) mk_fwd(Args args) {
    extern __shared__ __attribute__((aligned(16))) unsigned char lds_raw[];
    Frame F;
    F.lds = (LAS unsigned char*)lds_raw;
    F.tid = threadIdx.x; F.lane = F.tid & 63; F.wave = __builtin_amdgcn_readfirstlane(F.tid >> 6); F.G = gridDim.x; F.bid = blockIdx.x;
    unsigned char* ws = args.ws;
    F.in = args.in; F.ws = args.ws; F.H = args.out;

    for (int u = F.tid; u < (LDS_BYTES - LDSCTL_OFF) / 4; u += NTHR) ((LAS unsigned*)(F.lds + LDSCTL_OFF))[u] = 0u;
    __syncthreads();
    volatile LAS unsigned* MISC = (volatile LAS unsigned*)(F.lds + MISC_OFF);
    const bool multi = (args.ph_hi - args.ph_lo) > 1;
    XcdBarrier bar; bar.bar = (unsigned*)(ws + WS_CTL) + CW_BAR; bar.x = 0; bar.st = MISC + 8;
    if (multi) bar = xcd_barrier_post((unsigned*)(ws + WS_CTL) + CW_BAR, MISC + 8);

    const int lo = args.ph_lo, hi = args.ph_hi;
#define IN(k) (lo <= (k) && (k) < hi)
#define SEAM(k) do { if (IN(k) && IN((k) + 1)) xcd_barrier(bar); } while (0)
    const int gw = F.bid * NWAVES + F.wave, NGW = F.G * NWAVES;
    pg8::bf16_t* const WUP = (pg8::bf16_t*)(ws + WS_WUP); pg8::bf16_t* const WDN = (pg8::bf16_t*)(ws + WS_WDN);
    if (IN(0)) { ph_adaln(F); __syncthreads(); tr_ffn(F, F_ffn1_wg, F_ffn1_wu, F_ffn1_wd, gw, NGW); tr_misc(F, gw, NGW); } SEAM(0);
    if (IN(1)) { ph_norm_mod(F, F_x, F_ffn1_norm, 0 * D, 1 * D, F_XN); } SEAM(1);
    if (IN(2)) { pg8::Gemm g{F_XN, WUP, M, 2 * DFF, D, D, D}; pg8::StaticOrder S; S.init(M, 2 * DFF, F.G, F.bid);
        pg8::EpiSwiglu E{F_ACT, DFF}; pg8::gemm_phase<pg8::EpiSwiglu, pg8::StaticOrder, true, true>(F.lds, g, S, E); } SEAM(2);
    if (IN(3)) { pg8::Gemm g{F_ACT, WDN, M, D, DFF, DFF, DFF}; pg8::StaticOrder S; S.init(M, D, F.G, F.bid);
        pg8::EpiResid E{F_x, F.H, F_MOD + 2 * D, ADA, 0.5f}; pg8::gemm_phase<pg8::EpiResid, pg8::StaticOrder, false, true>(F.lds, g, S, E); } SEAM(3);
    if (IN(4)) { ph_norm_mod(F, F.H, F_mix_norm, 3 * D, 4 * D, F_XN); } SEAM(4);
    if (IN(5)) { pg8::Gemm g{F_XN, (pg8::bf16_t*)(ws + WS_WIN), M, 4352, D, D, D}; pg8::StaticOrder S; S.init(M, 4352, F.G, F.bid);
        pg8::EpiZ E{F_ZA, F_ZB, F_ZG}; pg8::gemm_phase<pg8::EpiZ, pg8::StaticOrder, true, true>(F.lds, g, S, E); } SEAM(5);
    if (IN(6)) { ph_mla_prep(F); ph_diff_prep(F); } SEAM(6);
    if (IN(7)) { ph_attention(F); } SEAM(7);
    if (IN(8)) { ph_subln(F); tr_ffn(F, F_ffn2_wg, F_ffn2_wu, F_ffn2_wd, gw, NGW); } SEAM(8);
    if (IN(9)) { pg8::StaticOrder S; S.init(M, D, F.G, F.bid);
        { pg8::Gemm g{F_OMD, (pg8::bf16_t*)(ws + WS_WO), M, D, 512, D, D}; pg8::EpiGate<0> E{F_MRG, F_ZG}; pg8::gemm_phase<pg8::EpiGate<0>, pg8::StaticOrder, false, true>(F.lds, g, S, E); }
        { pg8::Gemm g{F_OMD + 512, (pg8::bf16_t*)(ws + WS_WO) + 512, M, D, 512, D, D}; pg8::EpiGate<1> E{F_MRG, F_ZG}; pg8::gemm_phase<pg8::EpiGate<1>, pg8::StaticOrder, false, true>(F.lds, g, S, E); } } SEAM(9);
    if (IN(10)) { pg8::Gemm g{F_MRG, (pg8::bf16_t*)(ws + WS_WOUT), M, D, D, D, D}; pg8::StaticOrder S; S.init(M, D, F.G, F.bid);
        pg8::EpiResid E{F.H, F.H, F_MOD + 5 * D, ADA, 1.0f}; pg8::gemm_phase<pg8::EpiResid, pg8::StaticOrder, false, true>(F.lds, g, S, E); } SEAM(10);
    if (IN(11)) { ph_norm_mod(F, F.H, F_ffn2_norm, 6 * D, 7 * D, F_XN); } SEAM(11);
    if (IN(12)) { pg8::Gemm g{F_XN, WUP, M, 2 * DFF, D, D, D}; pg8::StaticOrder S; S.init(M, 2 * DFF, F.G, F.bid);
        pg8::EpiSwiglu E{F_ACT, DFF}; pg8::gemm_phase<pg8::EpiSwiglu, pg8::StaticOrder, true, true>(F.lds, g, S, E); } SEAM(12);
    if (IN(13)) { pg8::Gemm g{F_ACT, WDN, M, D, DFF, DFF, DFF}; pg8::StaticOrder S; S.init(M, D, F.G, F.bid);
        pg8::EpiResid E{F.H, F.H, F_MOD + 8 * D, ADA, 0.5f}; pg8::gemm_phase<pg8::EpiResid, pg8::StaticOrder, false, true>(F.lds, g, S, E); } SEAM(13);
    if (IN(14)) { ph_final_norm(F); }
#undef IN
#undef SEAM
}

#ifndef MK_ONE_LAUNCH
#define MK_ONE_LAUNCH 1
#endif

extern "C" void kernel_launch(void* const* d_in, const int* in_sizes, int n_in, void* d_out, int out_size, void* d_ws, size_t ws_size, hipStream_t stream) {
    static int grid = 0;
    if (grid == 0) {
        if (n_in != 32 || in_sizes[0] != M * D || out_size != M * D || ws_size < WS_END) {
            fprintf(stderr, "kernel_launch: unexpected shapes: n_in %d in0 %d out %d ws %zu (need %zu)\n", n_in, n_in > 0 ? in_sizes[0] : -1, out_size, ws_size, (size_t)WS_END); grid = -1; return; }
        int dev = 0, cus = 0, per_cu = 0;
        if (hipGetDevice(&dev) != hipSuccess || hipDeviceGetAttribute(&cus, hipDeviceAttributeMultiprocessorCount, dev) != hipSuccess) { grid = -1; return; }
        if (hipFuncSetAttribute((const void*)mk_fwd, hipFuncAttributeMaxDynamicSharedMemorySize, LDS_BYTES) != hipSuccess) { fprintf(stderr, "kernel_launch: hipFuncSetAttribute failed\n"); grid = -1; return; }
        if (hipOccupancyMaxActiveBlocksPerMultiprocessor(&per_cu, (const void*)mk_fwd, NTHR, LDS_BYTES) != hipSuccess || per_cu < 1) {
            fprintf(stderr, "kernel_launch: occupancy query says %d blocks per CU\n", per_cu); per_cu = 1; }
        (void)hipGetLastError();
        grid = cus;
    }
    if (grid < 0) return;
    if (hipMemsetAsync((char*)d_ws + WS_CTL, 0, CTL_ZERO_BYTES, stream) != hipSuccess) { fprintf(stderr, "kernel_launch: memset failed\n"); return; }
    Args a{};
    for (int i = 0; i < 32; ++i) a.in[i] = d_in[i];
    a.out = (float*)d_out; a.ws = (unsigned char*)d_ws;
#if MK_ONE_LAUNCH
    a.ph_lo = 0; a.ph_hi = NPH;
    hipLaunchKernelGGL(mk_fwd, dim3(grid), dim3(NTHR), LDS_BYTES, stream, a);
#else
    for (int p = 0; p < NPH; ++p) { a.ph_lo = p; a.ph_hi = p + 1; hipLaunchKernelGGL(mk_fwd, dim3(grid), dim3(NTHR), LDS_BYTES, stream, a); }
#endif
    const hipError_t le = hipPeekAtLastError();
    if (le != hipSuccess) fprintf(stderr, "kernel_launch: launch failed: %s\n", hipGetErrorName(le));
}
```

```cpp
#include <hip/hip_runtime.h>
#include <cstdio>
#include <cstdint>

constexpr int BATCH = 8, SEQ = 2048, D = 1024, M = BATCH * SEQ, DFF = 2816, ADA = 9 * D;
constexpr int QLORA = 384, KVLORA = 256, ROPE_A = 32, MLA_H = 8, MLA_QK = 96, MLA_NOPE = 64, MLA_V = 64;
constexpr int DF_H = 4, DF_D = 64, DF_V = 128, ROT = 16;
constexpr int IN_COLS = 4256;
constexpr int ZA_LD = 768, ZB_LD = 1536, ZG_LD = 2048;
constexpr float EPS = 1e-6f;
constexpr float LOG2E = 1.4426950408889634f;
constexpr float C2_MLA = 0.10206207261596577f * LOG2E;
constexpr float C2_DF = 0.125f * LOG2E;
constexpr float LAMBDA_INIT = 0.2f;
constexpr int NWAVES = 8, NTHR = 512;

constexpr size_t MiB = 1u << 20;
constexpr size_t WS_CTL = 0, CTL_ZERO_BYTES = 1 * MiB;
constexpr size_t WS_MOD = 1 * MiB;
constexpr size_t WS_WUP = 2 * MiB;
constexpr size_t WS_WDN = 13 * MiB;
constexpr size_t WS_VM = 2 * MiB;
constexpr size_t WS_WIN = 18 * MiB + 512 * 1024;
constexpr size_t WS_WO = 27 * MiB;
constexpr size_t WS_WOUT = 29 * MiB;
constexpr size_t WS_WUQ = 31 * MiB;
constexpr size_t WS_WUKV = 32 * MiB;
constexpr size_t WS_XN = 33 * MiB;
constexpr size_t WS_OMD = 33 * MiB;
constexpr size_t WS_BIG = 65 * MiB;
constexpr size_t WS_ACT = WS_BIG;
constexpr size_t WS_ZG = WS_BIG;
constexpr size_t WS_ZB = WS_BIG + 64 * MiB;
constexpr size_t WS_ZA = WS_BIG + 112 * MiB;
constexpr size_t WS_QM = WS_BIG + 136 * MiB;
constexpr size_t WS_KM = WS_BIG + 160 * MiB;
constexpr size_t WS_MRG = WS_QM;
constexpr size_t WS_END = WS_BIG + 184 * MiB;
constexpr int CW_BAR = 4096;

constexpr int LDS_BYTES = 147456, RING_BYTES = 131072, LDSCTL_OFF = RING_BYTES, MISC_OFF = LDSCTL_OFF + 320;

#define GAS __attribute__((address_space(1)))
#define LAS __attribute__((address_space(3)))
typedef unsigned short bf16;
typedef float f32x4 __attribute__((ext_vector_type(4)));

__device__ __forceinline__ float bf2f(bf16 v) { return __uint_as_float(((unsigned)v) << 16); }
__device__ __forceinline__ bf16 f2bf(float f) { unsigned u = __float_as_uint(f); return (bf16)((u + 0x7fffu + ((u >> 16) & 1u)) >> 16); }
__device__ __forceinline__ float silu_f(float v) { return v / (1.f + __expf(-v)); }
__device__ __forceinline__ float sigmoid_f(float v) { return 1.f / (1.f + __expf(-v)); }
__device__ __forceinline__ float wave_sum(float v) {
#pragma unroll
    for (int o = 1; o < 64; o <<= 1) v += __shfl_xor(v, o);
    return v;
}
__device__ __forceinline__ void sincos_red(float ang, float& sn, float& cs) {
    double t = (double)ang * 0.15915494309189535;
    t -= __builtin_rint(t);
    const float r = (float)t;
    sn = __builtin_amdgcn_sinf(r); cs = __builtin_amdgcn_cosf(r);
}

#define XB_TMO      128
#define XB_XCNT(j)  (256  + 64 * (j))
#define XB_XSUB(j)  (1280 + 64 * (j))
#define XB_XGEN(j)  (2304 + 64 * (j))
#define XB_TOP      3328
#define XB_TOPGEN   3392
#define XCD_BAR_WORDS 3456
#define XB_SPIN_CAP (1u << 24)
__device__ __forceinline__ unsigned xb_ld(unsigned* p)              { return __hip_atomic_load(p, __ATOMIC_RELAXED, __HIP_MEMORY_SCOPE_AGENT); }
__device__ __forceinline__ unsigned xb_add(unsigned* p, unsigned v) { return __hip_atomic_fetch_add(p, v, __ATOMIC_RELAXED, __HIP_MEMORY_SCOPE_AGENT); }
__device__ __forceinline__ unsigned xb_xcc_id() { return (unsigned)__builtin_amdgcn_s_getreg((3 << 11) | 20) & 0xFu; }
#define XB_SPIN(cond, bar) do { unsigned _sp = 0; while (cond) { __builtin_amdgcn_s_sleep(1); \
    if ((++_sp & 255u) == 0u) { if (xb_ld(&(bar)[XB_TMO])) break; if (_sp > XB_SPIN_CAP) { atomicAdd(&(bar)[XB_TMO], 1u); break; } } } } while (0)
struct XcdBarrier { unsigned* bar; unsigned x; volatile LAS unsigned* st; };
__device__ __forceinline__ XcdBarrier xcd_barrier_post(unsigned* bar, volatile LAS unsigned* st) {
    XcdBarrier b; b.bar = bar; b.x = xb_xcc_id(); b.st = st;
    if (threadIdx.x == 0) (void)xb_add(&bar[XB_XCNT(b.x)], 1u);
    return b;
}
__device__ __forceinline__ void xcd_barrier_complete(unsigned* bar, unsigned x, unsigned& nloc, unsigned& nx) {
    const unsigned G = gridDim.x * gridDim.y * gridDim.z;
    unsigned sum, cnt, mine, sp = 0u;
    for (;;) {
        sum = 0u; cnt = 0u; mine = 0u;
#pragma unroll
        for (unsigned j = 0; j < 16; ++j) { const unsigned c = xb_ld(&bar[XB_XCNT(j)]); sum += c; cnt += (c > 0u) ? 1u : 0u; mine = (j == x) ? c : mine; }
        if (sum == G) break;
        __builtin_amdgcn_s_sleep(1);
        if ((++sp & 255u) == 0u) { if (xb_ld(&bar[XB_TMO])) break; if (sp > XB_SPIN_CAP) { atomicAdd(&bar[XB_TMO], 1u); break; } }
    }
    nloc = mine > 0u ? mine : 1u; nx = cnt > 0u ? cnt : 1u;
}
__device__ __forceinline__ void xcd_barrier(const XcdBarrier& b) {
    asm volatile("s_waitcnt vmcnt(0)" ::: "memory");
    __syncthreads();
    if (threadIdx.x == 0) {
        unsigned* bar = b.bar;
        __builtin_amdgcn_s_waitcnt(0);
        unsigned nloc = b.st[0], nx = b.st[1];
        if (nloc == 0u) { xcd_barrier_complete(bar, b.x, nloc, nx); b.st[0] = nloc; b.st[1] = nx; }
        const unsigned old = xb_add(&bar[XB_XSUB(b.x)], 1u);
        const unsigned gen = old / nloc;
        if (old + 1u == (gen + 1u) * nloc) {
            __builtin_amdgcn_fence(__ATOMIC_RELEASE, "agent");
            asm volatile("s_waitcnt vmcnt(0)" ::: "memory");
            const unsigned og = xb_add(&bar[XB_TOP], 1u);
            const unsigned tg = og / nx;
            if (og + 1u == (tg + 1u) * nx) xb_add(&bar[XB_TOPGEN], 1u);
            else XB_SPIN(xb_ld(&bar[XB_TOPGEN]) == tg, bar);
            __builtin_amdgcn_fence(__ATOMIC_ACQUIRE, "agent");
            xb_add(&bar[XB_XGEN(b.x)], 1u);
            asm volatile("s_waitcnt vmcnt(0)" ::: "memory");
        } else {
            XB_SPIN(xb_ld(&bar[XB_XGEN(b.x)]) == gen, bar);
            __builtin_amdgcn_fence(__ATOMIC_ACQUIRE, "agent");
            asm volatile("s_waitcnt vmcnt(0)" ::: "memory");
        }
    }
    __syncthreads();
}

namespace pg8 {
#define PG8_LAS __attribute__((address_space(3)))
typedef unsigned short bf16_t;
typedef short bf16x8 __attribute__((ext_vector_type(8)));
typedef float f32x4 __attribute__((ext_vector_type(4)));
typedef unsigned u32x4 __attribute__((ext_vector_type(4)));
constexpr int BM = 256, BK = 64, HALF = 128, HTB = HALF * BK * 2  , STAGE_BYTES = 8 * HTB, NXCD = 8, WGM = 8;

__host__ __device__ __forceinline__ int lds_byte(int r, int c) { const int st = (r >> 4) * 2 + (c >> 5), rr = r & 15, cc = c & 31, ob = rr * 64 + cc * 2; return st * 1024 + (ob ^ (((ob >> 9) & 1) << 5)); }
__host__ __device__ __forceinline__ void stage_rc(int b, int& R, int& C) { const int st = b / 1024, sb = b % 1024, swz = sb ^ (((sb >> 9) & 1) << 5); R = (st >> 1) * 16 + swz / 64; C = (st & 1) * 32 + (swz % 64) / 2; }
__host__ __device__ __forceinline__ int perm32(int rho) { const int n = rho >> 4, i = rho & 15; return 8 * (i >> 2) + 4 * n + (i & 3); }

struct Unit { int pm, pn; };
struct Gemm { const bf16_t* A; const bf16_t* Bt; int M, N, K, lda, ldb; };

struct StaticOrder {
    int nM, nN, nwg, G, c;
    __host__ __device__ void init(int M, int N, int G_, int c_) { nM = M / BM; nN = N / BM; nwg = nM * nN; G = G_; c = c_; }
    __host__ __device__ bool next(int i, Unit& u) const {
        const long L = (long)i * G + c; if (L >= nwg) return false;
        int wgid = (int)L; { const int q = nwg / NXCD, r = nwg % NXCD, xcd = wgid % NXCD, off = wgid / NXCD; wgid = (xcd < r ? xcd * (q + 1) : r * (q + 1) + (xcd - r) * q) + off; }
        const int nig = WGM * nN, gid = wgid / nig, fm = gid * WGM, gsz = (nM - fm) < WGM ? (nM - fm) : WGM;
        u.pm = fm + ((wgid % nig) % gsz); u.pn = (wgid % nig) / gsz; return true;
    }
    __device__ __forceinline__ void a_ready(const Unit&) const {}
    __device__ __forceinline__ void done(const Unit&) const {}
};
__device__ __forceinline__ unsigned cvt_pk_bf16(float lo, float hi) { unsigned r; asm volatile("v_cvt_pk_bf16_f32 %0, %1, %2" : "=v"(r) : "v"(lo), "v"(hi)); return r; }
typedef float f32x2 __attribute__((ext_vector_type(2)));

__device__ __forceinline__ float fast_sigmoid(float v) { return __builtin_amdgcn_rcpf(1.0f + __builtin_amdgcn_exp2f(-1.4426950408889634f * v)); }
struct EpiSwiglu {
    static constexpr bool PERM = true, AFTER_DRAIN = false;
    bf16_t* O; int ldc;
    __device__ __forceinline__ void operator()(const f32x4 (&acc)[2][2][4][2], const Unit& u, int wr, int wc, int fr, int fq) const {
        const int row0 = u.pm * BM + wr * 64 + fr, col0 = u.pn * HALF + wc * 32 + 8 * fq;
#pragma unroll
        for (int ai = 0; ai < 2; ++ai)
#pragma unroll
            for (int m = 0; m < 4; ++m) { bf16_t* rowp = O + (size_t)(row0 + ai * HALF + m * 16) * ldc + col0;
                float v[8];
#pragma unroll
                for (int n = 0; n < 2; ++n)
#pragma unroll
                    for (int j = 0; j < 4; ++j) { const float g = acc[ai][0][m][n][j], up = acc[ai][1][m][n][j]; v[4 * n + j] = g * fast_sigmoid(g) * up; }
                u32x4 w; w.x = cvt_pk_bf16(v[0], v[1]); w.y = cvt_pk_bf16(v[2], v[3]); w.z = cvt_pk_bf16(v[4], v[5]); w.w = cvt_pk_bf16(v[6], v[7]);
                *(u32x4*)rowp = w; }
    }
};
struct EpiResid {
    static constexpr bool PERM = false, AFTER_DRAIN = false;
    const float* base; float* out; const float* gt; int gstride; float scale;
    __device__ __forceinline__ void operator()(const f32x4 (&acc)[2][2][4][2], const Unit& u, int wr, int wc, int fr, int fq) const {
        const int row0 = u.pm * BM + wr * 64 + fr, col0 = u.pn * BM + wc * 32 + 4 * fq;
        const float* gp = gt + (size_t)(u.pm >> 3) * gstride + col0;
        f32x4 gv[2][2];
#pragma unroll
        for (int bj = 0; bj < 2; ++bj)
#pragma unroll
            for (int n = 0; n < 2; ++n) gv[bj][n] = *(const f32x4*)(gp + bj * HALF + n * 16) * scale;
#pragma unroll
        for (int ai = 0; ai < 2; ++ai)
#pragma unroll
            for (int m = 0; m < 4; ++m) { const size_t off = (size_t)(row0 + ai * HALF + m * 16) * 1024 + col0;
#pragma unroll
                for (int bj = 0; bj < 2; ++bj)
#pragma unroll
                    for (int n = 0; n < 2; ++n) { const f32x4 bs = *(const f32x4*)(base + off + bj * HALF + n * 16);
                        *(f32x4*)(out + off + bj * HALF + n * 16) = bs + gv[bj][n] * acc[ai][bj][m][n]; } }
    }
};
struct EpiZ {
    static constexpr bool PERM = true, AFTER_DRAIN = false;
    bf16_t *ZA, *ZB, *ZG;
    __device__ __forceinline__ void operator()(const f32x4 (&acc)[2][2][4][2], const Unit& u, int wr, int wc, int fr, int fq) const {
        bf16_t* base; int ldc, ct;
        if (u.pn < 3) { base = ZA; ldc = 768; ct = u.pn; } else if (u.pn < 9) { base = ZB; ldc = 1536; ct = u.pn - 3; } else { base = ZG; ldc = 2048; ct = u.pn - 9; }
        const int row0 = u.pm * BM + wr * 64 + fr, col0 = ct * BM + wc * 32 + 8 * fq;
#pragma unroll
        for (int ai = 0; ai < 2; ++ai)
#pragma unroll
            for (int m = 0; m < 4; ++m) { bf16_t* rowp = base + (size_t)(row0 + ai * HALF + m * 16) * ldc + col0;
#pragma unroll
                for (int bj = 0; bj < 2; ++bj) { const f32x4 v0 = acc[ai][bj][m][0], v1 = acc[ai][bj][m][1];
                    u32x4 w; w.x = cvt_pk_bf16(v0[0], v0[1]); w.y = cvt_pk_bf16(v0[2], v0[3]); w.z = cvt_pk_bf16(v1[0], v1[1]); w.w = cvt_pk_bf16(v1[2], v1[3]);
                    *(u32x4*)(rowp + bj * HALF) = w; } }
    }
};
template <int PASS> struct EpiGate {
    static constexpr bool PERM = true, AFTER_DRAIN = false;
    bf16_t* O; const bf16_t* ZG;
    __device__ __forceinline__ void operator()(const f32x4 (&acc)[2][2][4][2], const Unit& u, int wr, int wc, int fr, int fq) const {
        const int row0 = u.pm * BM + wr * 64 + fr, col0 = u.pn * BM + wc * 32 + 8 * fq;
#pragma unroll
        for (int ai = 0; ai < 2; ++ai)
#pragma unroll
            for (int m = 0; m < 4; ++m) { const size_t r = (size_t)(row0 + ai * HALF + m * 16);
#pragma unroll
                for (int bj = 0; bj < 2; ++bj) {
                    const u32x4 gl = *(const u32x4*)(ZG + r * 2048 + PASS * 1024 + col0 + bj * HALF);
                    u32x4 prev = (u32x4){0u, 0u, 0u, 0u}; if (PASS == 1) prev = *(const u32x4*)(O + r * 1024 + col0 + bj * HALF);
                    float v[8];
#pragma unroll
                    for (int q = 0; q < 4; ++q) { const unsigned gw = gl[q], pw = prev[q];
                        const float g0 = __uint_as_float(gw << 16), g1 = __uint_as_float(gw & 0xffff0000u);
                        const float p0 = __uint_as_float(pw << 16), p1 = __uint_as_float(pw & 0xffff0000u);
                        const float a0 = acc[ai][bj][m][q >> 1][(q & 1) * 2], a1 = acc[ai][bj][m][q >> 1][(q & 1) * 2 + 1];
                        v[2 * q] = p0 + fast_sigmoid(g0) * a0; v[2 * q + 1] = p1 + fast_sigmoid(g1) * a1; }
                    u32x4 w; w.x = cvt_pk_bf16(v[0], v[1]); w.y = cvt_pk_bf16(v[2], v[3]); w.z = cvt_pk_bf16(v[4], v[5]); w.w = cvt_pk_bf16(v[6], v[7]);
                    *(u32x4*)(O + r * 1024 + col0 + bj * HALF) = w; } }
    }
};

template <class Epi, class Sched, bool ALIGN_EPI = false, bool SP2 = false>
__device__ __forceinline__ void gemm_phase(PG8_LAS unsigned char* lds, const Gemm g, const Sched& S, const Epi& E) {
    const int tid = threadIdx.x, wid = __builtin_amdgcn_readfirstlane(tid >> 6), lane = tid & 63, wr = wid >> 2, wc = wid & 3, fr = lane & 15, fq = lane >> 4;
    const int K = g.K, nt = K / BK;
    unsigned voffA[2], voffB[2];
#pragma unroll
    for (int i = 0; i < 2; ++i) { int R, C; stage_rc(tid * 16 + i * 8192, R, C); const int Rb = Epi::PERM ? ((R & ~31) + perm32(R & 31)) : R;
        voffA[i] = (unsigned)(R * g.lda + C) * 2u; voffB[i] = (unsigned)(Rb * g.ldb + C) * 2u; }
    const size_t kstep = (size_t)(BK * 2);
    const size_t hstepA = (size_t)HALF * g.lda * 2, hstepB = (size_t)HALF * g.ldb * 2;
    const size_t tstepA = 2 * hstepA, tstepB = 2 * hstepB;
    const unsigned ldsw = (unsigned)wid * 1024u;
    const int aoff = lds_byte(wr * 64 + fr, fq * 8), boff = lds_byte(wc * 32 + fr, fq * 8);
#define PG8_SA(b, h) (((b) * 2 + (h)) * HTB)
#define PG8_SB(b, h) ((4 + (b) * 2 + (h)) * HTB)
#define PG8_STAGE(bufoff, gbase, voff) do { _Pragma("unroll") for (int _i = 0; _i < 2; ++_i) \
        __builtin_amdgcn_global_load_lds((const unsigned*)((const char*)(gbase) + (voff)[_i]), (PG8_LAS unsigned*)(lds + (bufoff) + ldsw + _i * 8192), 16, 0, 0); } while (0)
#define PG8_LDA(dst, b, h) do { _Pragma("unroll") for (int m = 0; m < 4; ++m) _Pragma("unroll") for (int k = 0; k < 2; ++k) dst[m][k] = *(const PG8_LAS bf16x8*)(lds + PG8_SA(b, h) + aoff + m * 2048 + k * 1024); } while (0)
#define PG8_LDB(dst, b, h) do { _Pragma("unroll") for (int n = 0; n < 2; ++n) _Pragma("unroll") for (int k = 0; k < 2; ++k) dst[n][k] = *(const PG8_LAS bf16x8*)(lds + PG8_SB(b, h) + boff + n * 2048 + k * 1024); } while (0)
#define PG8_MMA(ai, bj, At, Bt) do { __builtin_amdgcn_s_setprio(1); _Pragma("unroll") for (int m = 0; m < 4; ++m) _Pragma("unroll") for (int n = 0; n < 2; ++n) _Pragma("unroll") for (int k = 0; k < 2; ++k) \
        acc[ai][bj][m][n] = __builtin_amdgcn_mfma_f32_16x16x32_bf16(Bt[n][k], At[m][k], acc[ai][bj][m][n], 0, 0, 0); __builtin_amdgcn_s_setprio(0); } while (0)
#define PG8_WAIT_V(n) asm volatile("s_waitcnt vmcnt(" #n ")" ::: "memory")
#define PG8_WAIT_L(n) asm volatile("s_waitcnt lgkmcnt(" #n ")" ::: "memory")
#define PG8_BAR __builtin_amdgcn_s_barrier()
#define PG8_SCHED __builtin_amdgcn_sched_barrier(0)
    Unit cur, nxt; int ui = 0;
    if (!S.next(0, cur)) return;
    f32x4 acc[2][2][4][2];
#pragma unroll
    for (int a = 0; a < 2; ++a)
#pragma unroll
        for (int b = 0; b < 2; ++b)
#pragma unroll
            for (int m = 0; m < 4; ++m)
#pragma unroll
                for (int n = 0; n < 2; ++n) acc[a][b][m][n] = (f32x4){0.f, 0.f, 0.f, 0.f};
    bf16x8 At[4][2], B0[2][2], B1[2][2];
    const char* cA = (const char*)g.A + (size_t)cur.pm * tstepA; const char* cB = (const char*)g.Bt + (size_t)cur.pn * tstepB;
    S.a_ready(cur);
    if constexpr (SP2) {
        PG8_STAGE(PG8_SB(0, 0), cB, voffB); PG8_STAGE(PG8_SB(0, 1), cB + hstepB, voffB); PG8_STAGE(PG8_SA(0, 0), cA, voffA); PG8_STAGE(PG8_SA(0, 1), cA + hstepA, voffA);
        if (wr == 1) PG8_BAR;
        PG8_WAIT_V(2); PG8_BAR;
        PG8_STAGE(PG8_SB(1, 0), cB + kstep, voffB); PG8_STAGE(PG8_SA(1, 0), cA + kstep, voffA); PG8_STAGE(PG8_SB(1, 1), cB + hstepB + kstep, voffB);
        PG8_WAIT_V(6); PG8_BAR;
    } else {
        PG8_STAGE(PG8_SB(0, 0), cB, voffB); PG8_STAGE(PG8_SA(0, 0), cA, voffA); PG8_STAGE(PG8_SB(0, 1), cB + hstepB, voffB); PG8_STAGE(PG8_SA(0, 1), cA + hstepA, voffA);
        if (wr == 1) PG8_BAR;
        PG8_WAIT_V(4); PG8_BAR;
        PG8_STAGE(PG8_SB(1, 0), cB + kstep, voffB); PG8_STAGE(PG8_SA(1, 0), cA + kstep, voffA); PG8_STAGE(PG8_SB(1, 1), cB + hstepB + kstep, voffB);
        PG8_WAIT_V(6); PG8_BAR;
    }
    for (;;) {
        const bool has_next = S.next(ui + 1, nxt);
        const char* nA = has_next ? (const char*)g.A + (size_t)nxt.pm * tstepA : cA; const char* nB = has_next ? (const char*)g.Bt + (size_t)nxt.pn * tstepB : cB;
        for (int t = 0; t < nt; t += 2) {
            const bool last = (t == nt - 2);
            const char* a1 = cA + (size_t)(t + 1) * kstep;
            const char* a2 = last ? nA : cA + (size_t)(t + 2) * kstep; const char* b2 = last ? nB : cB + (size_t)(t + 2) * kstep;
            const char* a3 = a2 + kstep; const char* b3 = b2 + kstep;
            if (last && has_next) S.a_ready(nxt);
            if constexpr (SP2) {
            PG8_LDB(B0, 0, 0); PG8_LDB(B1, 0, 1); PG8_SCHED; PG8_LDA(At, 0, 0); PG8_STAGE(PG8_SA(1, 1), a1 + hstepA, voffA);
            PG8_WAIT_V(8); PG8_WAIT_L(0); PG8_BAR; PG8_MMA(0, 0, At, B0); PG8_MMA(0, 1, At, B1); PG8_BAR; PG8_SCHED;
            PG8_LDA(At, 0, 1); PG8_STAGE(PG8_SB(0, 0), b2, voffB); PG8_STAGE(PG8_SB(0, 1), b2 + hstepB, voffB); PG8_STAGE(PG8_SA(0, 0), a2, voffA);
            PG8_WAIT_V(8); PG8_WAIT_L(0); PG8_BAR; PG8_MMA(1, 0, At, B0); PG8_MMA(1, 1, At, B1); PG8_BAR; PG8_SCHED;
            PG8_LDB(B0, 1, 0); PG8_LDB(B1, 1, 1); PG8_SCHED; PG8_LDA(At, 1, 0); PG8_STAGE(PG8_SA(0, 1), a2 + hstepA, voffA);
            PG8_WAIT_V(8); PG8_WAIT_L(0); PG8_BAR; PG8_MMA(0, 0, At, B0); PG8_MMA(0, 1, At, B1); PG8_BAR; PG8_SCHED;
            PG8_LDA(At, 1, 1); PG8_STAGE(PG8_SB(1, 0), b3, voffB); PG8_STAGE(PG8_SB(1, 1), b3 + hstepB, voffB); PG8_STAGE(PG8_SA(1, 0), a3, voffA);
            PG8_WAIT_V(8); PG8_WAIT_L(0); PG8_BAR; PG8_MMA(1, 0, At, B0); PG8_MMA(1, 1, At, B1); PG8_BAR; PG8_SCHED;
            } else {
            PG8_LDB(B0, 0, 0); PG8_SCHED; PG8_LDA(At, 0, 0); PG8_STAGE(PG8_SA(1, 1), a1 + hstepA, voffA);
            PG8_WAIT_L(8); PG8_BAR; PG8_WAIT_L(0); PG8_MMA(0, 0, At, B0); PG8_BAR; PG8_SCHED;
            PG8_LDB(B1, 0, 1); PG8_STAGE(PG8_SB(0, 0), b2, voffB);
            PG8_BAR; PG8_WAIT_L(0); PG8_MMA(0, 1, At, B1); PG8_BAR;
            PG8_LDA(At, 0, 1); PG8_STAGE(PG8_SA(0, 0), a2, voffA);
            PG8_BAR; PG8_WAIT_L(0); PG8_MMA(1, 0, At, B0); PG8_BAR; PG8_SCHED;
            PG8_STAGE(PG8_SB(0, 1), b2 + hstepB, voffB);
            PG8_WAIT_V(6); PG8_BAR; PG8_MMA(1, 1, At, B1); PG8_BAR;
            PG8_LDB(B0, 1, 0); PG8_SCHED; PG8_LDA(At, 1, 0); PG8_STAGE(PG8_SA(0, 1), a2 + hstepA, voffA);
            PG8_WAIT_L(8); PG8_BAR; PG8_WAIT_L(0); PG8_MMA(0, 0, At, B0); PG8_BAR; PG8_SCHED;
            PG8_LDB(B1, 1, 1); PG8_STAGE(PG8_SB(1, 0), b3, voffB);
            PG8_BAR; PG8_WAIT_L(0); PG8_MMA(0, 1, At, B1); PG8_BAR;
            PG8_LDA(At, 1, 1); PG8_STAGE(PG8_SA(1, 0), a3, voffA);
            PG8_BAR; PG8_WAIT_L(0); PG8_MMA(1, 0, At, B0); PG8_BAR; PG8_SCHED;
            PG8_STAGE(PG8_SB(1, 1), b3 + hstepB, voffB);
            PG8_WAIT_V(6); PG8_BAR; PG8_MMA(1, 1, At, B1); PG8_BAR;
            }
        }
        if constexpr (ALIGN_EPI) { if (wr == 0) PG8_BAR; }
        if constexpr (!Epi::AFTER_DRAIN) { E(acc, cur, wr, wc, fr, fq); S.done(cur); }
        if (!has_next) break;
#pragma unroll
        for (int a = 0; a < 2; ++a)
#pragma unroll
            for (int b = 0; b < 2; ++b)
#pragma unroll
                for (int m = 0; m < 4; ++m)
#pragma unroll
                    for (int n = 0; n < 2; ++n) acc[a][b][m][n] = (f32x4){0.f, 0.f, 0.f, 0.f};
        cur = nxt; cA = nA; cB = nB; ++ui;
        if constexpr (ALIGN_EPI) { if (wr == 1) PG8_BAR; }
    }
    PG8_WAIT_V(0);
    if constexpr (!ALIGN_EPI) { if (wr == 0) PG8_BAR; }
    PG8_BAR;
    if constexpr (Epi::AFTER_DRAIN) { E.fused(acc, cur, wr, wc, fr, fq, lds, wid, lane); S.done(cur); }
#undef PG8_SA
#undef PG8_SB
#undef PG8_STAGE
#undef PG8_LDA
#undef PG8_LDB
#undef PG8_MMA
#undef PG8_WAIT_V
#undef PG8_WAIT_L
#undef PG8_BAR
#undef PG8_SCHED
}
}

namespace attn {
using bf16x8 = __attribute__((ext_vector_type(8))) short;
using s16x4  = __attribute__((ext_vector_type(4))) short;
using f32x16 = __attribute__((ext_vector_type(16))) float;
using u32x4  = __attribute__((ext_vector_type(4))) unsigned;
constexpr int NW = 8, QBLK = 32, KVBLK = 64, SHM_V = 16384, SHM_K = 16384, LDS_WS = 2 * SHM_V + 2 * SHM_K;
constexpr float THRL = 8.f;
#define ATT_KSWZ(row, colB) ((row) * 256 + ((colB) ^ (((row) & 7) << 4)))
#define ATT_SBAR() __builtin_amdgcn_sched_barrier(0)
__device__ __forceinline__ int crow(int r, int hi) { return (r & 3) + 8 * (r >> 2) + 4 * hi; }
__device__ __forceinline__ unsigned cvtpk(float lo, float hi) { unsigned r; asm volatile("v_cvt_pk_bf16_f32 %0, %1, %2" : "=v"(r) : "v"(lo), "v"(hi)); return r; }
__device__ __forceinline__ void partialSM(f32x16& p0, f32x16& p1, float& m_reg, float& mn, float& alpha) {
  float pmax = p0[0];
#pragma unroll
  for (int r = 1; r < 16; ++r) pmax = fmaxf(pmax, p0[r]);
#pragma unroll
  for (int r = 0; r < 16; ++r) pmax = fmaxf(pmax, p1[r]);
  { auto rr = __builtin_amdgcn_permlane32_swap(__float_as_uint(pmax), __float_as_uint(pmax), false, false);
    pmax = fmaxf(__uint_as_float(rr[0]), __uint_as_float(rr[1])); }
  if (__builtin_expect(__all(pmax - m_reg <= THRL), 1)) { mn = m_reg; alpha = 1.f; }
  else { mn = fmaxf(m_reg, pmax); alpha = __builtin_amdgcn_exp2f(m_reg - mn); m_reg = mn; }
#pragma unroll
  for (int r = 0; r < 16; ++r) { p0[r] = p0[r] - mn; p1[r] = p1[r] - mn; }
#pragma unroll
  for (int r = 0; r < 16; ++r) p0[r] = __builtin_amdgcn_exp2f(p0[r]);
}
__device__ __forceinline__ void finishSM(f32x16& p0, f32x16& p1, float alpha, float& l_reg, bf16x8& pa0, bf16x8& pa1, bf16x8& pa2, bf16x8& pa3) {
#pragma unroll
  for (int r = 0; r < 16; ++r) p1[r] = __builtin_amdgcn_exp2f(p1[r]);
  float ps = 0;
#pragma unroll
  for (int r = 0; r < 16; ++r) ps += p0[r];
#pragma unroll
  for (int r = 0; r < 16; ++r) ps += p1[r];
  { auto rr = __builtin_amdgcn_permlane32_swap(__float_as_uint(ps), __float_as_uint(ps), false, false);
    ps = __uint_as_float(rr[0]) + __uint_as_float(rr[1]); }
  l_reg = l_reg * alpha + ps;
#define ATT_PK4(P, BASE, OUT) do { unsigned a0 = cvtpk(P[BASE + 0], P[BASE + 1]), a1 = cvtpk(P[BASE + 2], P[BASE + 3]);   \
    unsigned b0 = cvtpk(P[BASE + 4], P[BASE + 5]), b1 = cvtpk(P[BASE + 6], P[BASE + 7]);                              \
    auto r0 = __builtin_amdgcn_permlane32_swap(a0, b0, false, false); auto r1 = __builtin_amdgcn_permlane32_swap(a1, b1, false, false); \
    u32x4 w = {r0[0], r1[0], r0[1], r1[1]}; OUT = __builtin_bit_cast(bf16x8, w); } while (0)
  ATT_PK4(p0, 0, pa0); ATT_PK4(p0, 8, pa1); ATT_PK4(p1, 0, pa2); ATT_PK4(p1, 8, pa3);
#undef ATT_PK4
}
template <int DQK> __device__ __forceinline__ void qkt(f32x16& p0, f32x16& p1, const LAS char* Ks, const bf16x8* qr, int r32, int hi) {
  p0 = f32x16{}; p1 = f32x16{};
#pragma unroll
  for (int d0 = 0; d0 < DQK / 16; ++d0) { const int cb = (d0 * 16 + hi * 8) * 2;
    const bf16x8 b0 = *reinterpret_cast<const LAS bf16x8*>(Ks + ATT_KSWZ(r32, cb));
    const bf16x8 b1 = *reinterpret_cast<const LAS bf16x8*>(Ks + ATT_KSWZ(32 + r32, cb));
    p0 = __builtin_amdgcn_mfma_f32_32x32x16_bf16(b0, qr[d0], p0, 0, 0, 0);
    p1 = __builtin_amdgcn_mfma_f32_32x32x16_bf16(b1, qr[d0], p1, 0, 0, 0); }
}
__device__ __forceinline__ int v_st(int k, int c) { const int kk = (k & ~0xC) | ((k & 4) << 1) | ((k & 8) >> 1); return ((kk >> 3) * 4 + (c >> 5)) * 512 + ((kk & 7) * 32 + (c & 31)) * 2; }
__device__ __forceinline__ int v_rd_base(int lane) { return ((lane & 3) << 3) | (((lane >> 2) & 3) << 6) | (((lane >> 4) & 1) << 5) | (((lane >> 5) & 1) << 8); }
constexpr int v_rd_off(int d0, int ks, int half) { return d0 * 512 + ks * 4096 + half * 2048; }
template <int OFF> __device__ __forceinline__ s16x4 tr_read(int vb) { s16x4 r; asm volatile("ds_read_b64_tr_b16 %0, %1 offset:%2" : "=&v"(r) : "v"(vb), "i"(OFF) : "memory"); return r; }
template <int D0> __device__ __forceinline__ void pv_one(f32x16& od, int vb, bf16x8 pa0, bf16x8 pa1, bf16x8 pa2, bf16x8 pa3) {
  const s16x4 l0 = tr_read<v_rd_off(D0, 0, 0)>(vb), h0 = tr_read<v_rd_off(D0, 0, 1)>(vb), l1 = tr_read<v_rd_off(D0, 1, 0)>(vb), h1 = tr_read<v_rd_off(D0, 1, 1)>(vb);
  const s16x4 l2 = tr_read<v_rd_off(D0, 2, 0)>(vb), h2 = tr_read<v_rd_off(D0, 2, 1)>(vb), l3 = tr_read<v_rd_off(D0, 3, 0)>(vb), h3 = tr_read<v_rd_off(D0, 3, 1)>(vb);
  asm volatile("s_waitcnt lgkmcnt(0)" ::: "memory"); ATT_SBAR();
#define ATT_PK(L, H) (bf16x8){L[0], L[1], L[2], L[3], H[0], H[1], H[2], H[3]}
  od = __builtin_amdgcn_mfma_f32_32x32x16_bf16(pa0, ATT_PK(l0, h0), od, 0, 0, 0);
  od = __builtin_amdgcn_mfma_f32_32x32x16_bf16(pa1, ATT_PK(l1, h1), od, 0, 0, 0);
  od = __builtin_amdgcn_mfma_f32_32x32x16_bf16(pa2, ATT_PK(l2, h2), od, 0, 0, 0);
  od = __builtin_amdgcn_mfma_f32_32x32x16_bf16(pa3, ATT_PK(l3, h3), od, 0, 0, 0);
#undef ATT_PK
}
template <int DV> __device__ __forceinline__ void pv_all(f32x16 (&o)[DV / 32], int vb, bf16x8 pa0, bf16x8 pa1, bf16x8 pa2, bf16x8 pa3) {
  pv_one<0>(o[0], vb, pa0, pa1, pa2, pa3); pv_one<1>(o[1], vb, pa0, pa1, pa2, pa3);
  if constexpr (DV == 128) { pv_one<2>(o[2], vb, pa0, pa1, pa2, pa3); pv_one<3>(o[3], vb, pa0, pa1, pa2, pa3); }
}
template <int DQK, int DV>
__device__ __forceinline__ void sweep(const bf16* __restrict__ Qb, int ldq, const bf16* __restrict__ Kh, int ldk, const bf16* __restrict__ Vh, int ldv,
                                      f32x16 (&o)[DV / 32], float& l_out, LAS char* lds) {
  int tid_ = threadIdx.x; asm volatile("" : "+v"(tid_));
  const int tid = tid_, wid = tid >> 6, lane = tid & 63, r32 = lane & 31, hi = lane >> 5;
  LAS char* V_lds = lds; LAS char* K_lds = lds + 2 * SHM_V;
  LAS float* al_l = (LAS float*)(lds + LDS_WS) + wid * 64 + 32;
  float m_reg = -1e30f, l_reg = 0;
#pragma unroll
  for (int d = 0; d < DV / 32; ++d) o[d] = f32x16{};
  bf16x8 qr[DQK / 16];
  const bf16* Qw = Qb + (long)(wid * QBLK + r32) * ldq + hi * 8;
#pragma unroll
  for (int d0 = 0; d0 < DQK / 16; ++d0) qr[d0] = *reinterpret_cast<const bf16x8*>(Qw + d0 * 16);
  constexpr bool K2 = (DQK > 64), V2 = (DV > 64);
  static_assert(K2 != V2, "exactly one of K / V is a two-load operand (vmcnt(3) below counts three loads per tile)");
  const int sr = tid >> 4, sc = (tid & 15) * 8, sr1 = tid >> 3, sc1 = (tid & 7) * 8;
  const int vst0 = V2 ? v_st(sr, sc) : v_st(sr1, sc1), vst1 = v_st(32 + sr, sc);
  const int kst0 = K2 ? ATT_KSWZ(sr, sc * 2) : ATT_KSWZ(sr1, sc1 * 2), kst1 = ATT_KSWZ(32 + sr, sc * 2);
  const int vb0 = (int)(unsigned)(uintptr_t)V_lds + v_rd_base(lane);
  bf16x8 sE_v0, sE_v1, sE_k0, sE_k1, sO_v0, sO_v1, sO_k0, sO_k1;
#define ATT_SLOAD(S, k0) do { \
    if constexpr (V2) { S##_v0 = *reinterpret_cast<const bf16x8*>(&Vh[(long)((k0) + sr) * ldv + sc]); S##_v1 = *reinterpret_cast<const bf16x8*>(&Vh[(long)((k0) + 32 + sr) * ldv + sc]); } \
    else S##_v0 = *reinterpret_cast<const bf16x8*>(&Vh[(long)((k0) + sr1) * ldv + sc1]); \
    if constexpr (K2) { S##_k0 = *reinterpret_cast<const bf16x8*>(&Kh[(long)((k0) + sr) * ldk + sc]); S##_k1 = *reinterpret_cast<const bf16x8*>(&Kh[(long)((k0) + 32 + sr) * ldk + sc]); } \
    else S##_k0 = *reinterpret_cast<const bf16x8*>(&Kh[(long)((k0) + sr1) * ldk + sc1]); } while (0)
#define ATT_SWRITE(b, S) do { *(LAS bf16x8*)(V_lds + (b) * SHM_V + vst0) = S##_v0; if constexpr (V2) *(LAS bf16x8*)(V_lds + (b) * SHM_V + vst1) = S##_v1; \
    *(LAS bf16x8*)(K_lds + (b) * SHM_K + kst0) = S##_k0; if constexpr (K2) *(LAS bf16x8*)(K_lds + (b) * SHM_K + kst1) = S##_k1; } while (0)
#define ATT_SWAIT() asm volatile("s_waitcnt vmcnt(3)" ::: "memory")
#define ATT_RESC(a) do { if (__any((a) < 1.f)) { if (hi == 0) al_l[r32] = (a); asm volatile("s_waitcnt lgkmcnt(0)" ::: "memory"); \
    _Pragma("unroll") for (int d = 0; d < DV / 32; ++d) _Pragma("unroll") for (int r = 0; r < 16; ++r) o[d][r] *= al_l[crow(r, hi)]; } } while (0)
  f32x16 pA0, pA1, pB0, pB1; float mnA, mnB, alA, alB; bf16x8 pa0, pa1, pa2, pa3; constexpr int NT = SEQ / KVBLK;
  ATT_SLOAD(sE, 0); asm volatile("s_waitcnt vmcnt(0)" ::: "memory"); ATT_SWRITE(0, sE); __syncthreads();
  qkt<DQK>(pA0, pA1, K_lds, qr, r32, hi); partialSM(pA0, pA1, m_reg, mnA, alA);
  ATT_SLOAD(sO, KVBLK); ATT_SLOAD(sE, 2 * KVBLK);
  ATT_SWAIT(); ATT_SWRITE(1, sO); __syncthreads();
  for (int j = 1; j + 1 < NT; j += 2) {
    ATT_SBAR(); qkt<DQK>(pB0, pB1, K_lds + SHM_K, qr, r32, hi);
    finishSM(pA0, pA1, alA, l_reg, pa0, pa1, pa2, pa3); ATT_SBAR();
    ATT_SLOAD(sO, (j + 2) * KVBLK); ATT_SBAR();
    pv_all<DV>(o, vb0, pa0, pa1, pa2, pa3); partialSM(pB0, pB1, m_reg, mnB, alB);
    __syncthreads(); ATT_SWAIT(); ATT_SWRITE(0, sE);
    ATT_RESC(alB); __syncthreads();
    ATT_SBAR(); qkt<DQK>(pA0, pA1, K_lds, qr, r32, hi);
    finishSM(pB0, pB1, alB, l_reg, pa0, pa1, pa2, pa3); ATT_SBAR();
    if (j + 3 < NT) ATT_SLOAD(sE, (j + 3) * KVBLK); ATT_SBAR();
    pv_all<DV>(o, vb0 + SHM_V, pa0, pa1, pa2, pa3); partialSM(pA0, pA1, m_reg, mnA, alA);
    __syncthreads(); ATT_SWAIT(); ATT_SWRITE(1, sO);
    ATT_RESC(alA); __syncthreads();
  }
  ATT_SBAR(); qkt<DQK>(pB0, pB1, K_lds + SHM_K, qr, r32, hi);
  finishSM(pA0, pA1, alA, l_reg, pa0, pa1, pa2, pa3); ATT_SBAR();
  pv_all<DV>(o, vb0, pa0, pa1, pa2, pa3); partialSM(pB0, pB1, m_reg, mnB, alB);
  __syncthreads(); ATT_RESC(alB);
  finishSM(pB0, pB1, alB, l_reg, pa0, pa1, pa2, pa3); ATT_SBAR();
  pv_all<DV>(o, vb0 + SHM_V, pa0, pa1, pa2, pa3);
  l_out = l_reg;
  asm volatile("s_waitcnt vmcnt(0) lgkmcnt(0)" ::: "memory"); __syncthreads();
#undef ATT_SLOAD
#undef ATT_SWRITE
#undef ATT_SWAIT
#undef ATT_RESC
}
__device__ __forceinline__ void row_recip(float l_reg, float (&rli)[16], LAS char* lds, int wid, int r32, int hi) {
  LAS float* li_l = (LAS float*)(lds + LDS_WS) + wid * 64;
  if (hi == 0) li_l[r32] = l_reg; asm volatile("s_waitcnt lgkmcnt(0)" ::: "memory");
#pragma unroll
  for (int r = 0; r < 16; ++r) rli[r] = __builtin_amdgcn_rcpf(li_l[crow(r, hi)]);
  asm volatile("s_waitcnt lgkmcnt(0)" ::: "memory");
}
}
struct Args { const void* in[32]; float* out; unsigned char* ws; int ph_lo, ph_hi; };

struct Frame {
    LAS unsigned char* lds;
    int tid, lane, wave, G, bid;
    const void* const* in;
    unsigned char* ws; float* H;
};
#define FIN(i) ((const float*)F.in[i])
#define F_x FIN(0)
#define F_c FIN(1)
#define F_pos ((const int*)F.in[2])
#define F_w_ada FIN(3)
#define F_b_ada FIN(4)
#define F_ffn1_norm FIN(5)
#define F_ffn1_wg FIN(6)
#define F_ffn1_wu FIN(7)
#define F_ffn1_wd FIN(8)
#define F_mix_norm FIN(9)
#define F_w_in FIN(10)
#define F_q_norm FIN(11)
#define F_w_uq FIN(12)
#define F_kv_norm FIN(13)
#define F_w_ukv FIN(14)
#define F_q_gain FIN(15)
#define F_k_gain FIN(16)
#define F_mla_wo FIN(17)
#define F_dq_gain FIN(18)
#define F_dk_gain FIN(19)
#define F_lq1 FIN(20)
#define F_lk1 FIN(21)
#define F_lq2 FIN(22)
#define F_lk2 FIN(23)
#define F_subln FIN(24)
#define F_diff_wo FIN(25)
#define F_w_out FIN(26)
#define F_ffn2_norm FIN(27)
#define F_ffn2_wg FIN(28)
#define F_ffn2_wu FIN(29)
#define F_ffn2_wd FIN(30)
#define F_final_norm FIN(31)
#define F_MOD ((float*)(F.ws + WS_MOD))
#define F_XN ((bf16*)(F.ws + WS_XN))
#define F_ACT ((bf16*)(F.ws + WS_ACT))
#define F_ZA ((bf16*)(F.ws + WS_ZA))
#define F_ZB ((bf16*)(F.ws + WS_ZB))
#define F_ZG ((bf16*)(F.ws + WS_ZG))
#define F_QM ((bf16*)(F.ws + WS_QM))
#define F_KM ((bf16*)(F.ws + WS_KM))
#define F_VM ((bf16*)(F.ws + WS_VM))
#define F_OMD ((bf16*)(F.ws + WS_OMD))
#define F_MRG ((bf16*)(F.ws + WS_MRG))


typedef unsigned v4u __attribute__((ext_vector_type(4)));
__device__ __forceinline__ unsigned pk2(float lo, float hi) { return (unsigned)f2bf(lo) | ((unsigned)f2bf(hi) << 16); }
__device__ __forceinline__ void tr_item(const float* W, int ldw, int k0, int n0, bf16* WT, int ldk, int drow0, int dk0, LAS float* scr, int lane) {
#pragma unroll 8
    for (int i = 0; i < 32; ++i) { const int kk = 2 * i + (lane >> 5); scr[kk * 33 + (lane & 31)] = W[(size_t)(k0 + kk) * ldw + n0 + (lane & 31)]; }
    asm volatile("s_waitcnt lgkmcnt(0)" ::: "memory");
    const int c = lane & 7;
#pragma unroll
    for (int j = 0; j < 4; ++j) { const int n = (lane >> 3) + 8 * j; const LAS float* s = scr + (8 * c) * 33 + n;
        v4u o; o.x = pk2(s[0 * 33], s[1 * 33]); o.y = pk2(s[2 * 33], s[3 * 33]); o.z = pk2(s[4 * 33], s[5 * 33]); o.w = pk2(s[6 * 33], s[7 * 33]);
        *(v4u*)(WT + (size_t)(drow0 + n) * ldk + dk0 + k0 + 8 * c) = o; }
    asm volatile("s_waitcnt lgkmcnt(0)" ::: "memory");
}
constexpr int IT_FFN_GU = (D / 64) * (DFF / 32), IT_FFN_D = (DFF / 64) * (D / 32);
__device__ __forceinline__ void tr_ffn(Frame& F, const float* wg, const float* wu, const float* wd, int gw, int NGW) {
    LAS float* scr = (LAS float*)(F.lds + F.wave * 16384);
    bf16* WUP = (bf16*)(F.ws + WS_WUP); bf16* WDN = (bf16*)(F.ws + WS_WDN);
    for (int it = gw; it < 2 * IT_FFN_GU + IT_FFN_D; it += NGW) {
        if (it < 2 * IT_FFN_GU) { const int up = it >= IT_FFN_GU, r = up ? it - IT_FFN_GU : it, nblk = DFF / 32, kb = r / nblk, nb = r % nblk, n0 = 32 * nb;
            tr_item(up ? wu : wg, DFF, 64 * kb, n0, WUP, D, 256 * (n0 >> 7) + (n0 & 127) + 128 * up, 0, scr, F.lane); }
        else { const int r = it - 2 * IT_FFN_GU, nblk = D / 32, kb = r / nblk, nb = r % nblk;
            tr_item(wd, D, 64 * kb, 32 * nb, WDN, DFF, 32 * nb, 0, scr, F.lane); }
    }
}
constexpr int IT_WIN = (D / 64) * (IN_COLS / 32), IT_WO = (512 / 64) * (D / 32), IT_WOUT = (D / 64) * (D / 32);
__device__ __forceinline__ void tr_misc(Frame& F, int gw, int NGW) {
    LAS float* scr = (LAS float*)(F.lds + F.wave * 16384);
    bf16* WIN = (bf16*)(F.ws + WS_WIN); bf16* WO = (bf16*)(F.ws + WS_WO); bf16* WOUT = (bf16*)(F.ws + WS_WOUT);
    for (int it = gw; it < IT_WIN + 2 * IT_WO + IT_WOUT; it += NGW) {
        int r = it;
        if (r < IT_WIN) { const int nblk = IN_COLS / 32, kb = r / nblk, nb = r % nblk, n0 = 32 * nb;
            tr_item(F_w_in, IN_COLS, 64 * kb, n0, WIN, D, n0 < 672 ? n0 : n0 + 96, 0, scr, F.lane); continue; } r -= IT_WIN;
        if (r < 2 * IT_WO) { const int second = r >= IT_WO, q = second ? r - IT_WO : r, nblk = D / 32, kb = q / nblk, nb = q % nblk;
            tr_item(second ? F_diff_wo : F_mla_wo, D, 64 * kb, 32 * nb, WO, D, 32 * nb, 512 * second, scr, F.lane); continue; } r -= 2 * IT_WO;
        { const int nblk = D / 32, kb = r / nblk, nb = r % nblk; tr_item(F_w_out, D, 64 * kb, 32 * nb, WOUT, D, 32 * nb, 0, scr, F.lane); }
    }
    for (int i = gw * 64 + F.lane; i < 96 * D / 8; i += NGW * 64) *(v4u*)(WIN + (size_t)672 * D + (size_t)i * 8) = (v4u){0u, 0u, 0u, 0u};
}
__device__ __forceinline__ void ph_adaln(Frame& F) {
    LAS float* condL = (LAS float*)F.lds;
    LAS float* red = condL + 8 * 1024;
    for (int i = F.tid; i < 8 * 1024; i += NTHR) condL[i] = silu_f(F_c[i]);
    __syncthreads();
    constexpr int CPB = ADA / 256;
    for (int it = F.bid; it < 256; it += F.G) {
        const int n0 = it * CPB, col = F.tid % CPB, kg = F.tid / CPB;
        float acc[8];
#pragma unroll
        for (int b = 0; b < 8; ++b) acc[b] = 0.f;
        if (kg < 14) for (int k = kg; k < D; k += 14) { const float w = F_w_ada[(size_t)k * ADA + n0 + col];
#pragma unroll
            for (int b = 0; b < 8; ++b) acc[b] += condL[b * 1024 + k] * w; }
        if (kg < 14) {
#pragma unroll
            for (int b = 0; b < 8; ++b) red[(kg * CPB + col) * 8 + b] = acc[b]; }
        __syncthreads();
        if (F.tid < CPB * 8) { const int cc = F.tid / 8, b = F.tid % 8; float s = F_b_ada[n0 + cc];
            for (int g = 0; g < 14; ++g) s += red[(g * CPB + cc) * 8 + b];
            F_MOD[b * ADA + n0 + cc] = s; }
        __syncthreads();
    }
}
__device__ __forceinline__ void ph_norm_mod(Frame& F, const float* src, const float* gain, int sh_off, int sc_off, bf16* dst) {
    const int gw = F.bid * NWAVES + F.wave, NGW = F.G * NWAVES;
    for (int m = gw; m < M; m += NGW) {
        const int b = m / SEQ;
        const f32x4* xr = (const f32x4*)(src + (size_t)m * D) + F.lane;
        f32x4 v[4]; float s = 0.f;
#pragma unroll
        for (int j = 0; j < 4; ++j) { v[j] = xr[64 * j]; s += (v[j].x * v[j].x + v[j].y * v[j].y) + (v[j].z * v[j].z + v[j].w * v[j].w); }
        const float rstd = 1.f / sqrtf(wave_sum(s) * (1.f / D) + EPS);
#pragma unroll
        for (int j = 0; j < 4; ++j) {
            const int c0 = 4 * F.lane + 256 * j;
            const f32x4 g = *(const f32x4*)(gain + c0), sc = *(const f32x4*)(F_MOD + b * ADA + sc_off + c0), sh = *(const f32x4*)(F_MOD + b * ADA + sh_off + c0);
            const f32x4 o = v[j] * rstd * g * (1.f + sc) + sh;
            ushort4 w; w.x = f2bf(o.x); w.y = f2bf(o.y); w.z = f2bf(o.z); w.w = f2bf(o.w);
            *(ushort4*)(dst + (size_t)m * D + c0) = w;
        }
    }
}
__device__ __forceinline__ void ph_final_norm(Frame& F) {
    const int gw = F.bid * NWAVES + F.wave, NGW = F.G * NWAVES;
    for (int m = gw; m < M; m += NGW) {
        f32x4* xr = (f32x4*)(F.H + (size_t)m * D) + F.lane;
        f32x4 v[4]; float s = 0.f;
#pragma unroll
        for (int j = 0; j < 4; ++j) { v[j] = xr[64 * j]; s += (v[j].x * v[j].x + v[j].y * v[j].y) + (v[j].z * v[j].z + v[j].w * v[j].w); }
        const float rstd = 1.f / sqrtf(wave_sum(s) * (1.f / D) + EPS);
#pragma unroll
        for (int j = 0; j < 4; ++j) { const f32x4 g = *(const f32x4*)(F_final_norm + 4 * F.lane + 256 * j); xr[64 * j] = v[j] * rstd * g; }
    }
}

template <int R, int NMAT, class Epi>
__device__ __forceinline__ void naive_gemm(Frame& F, const bf16* A0, const bf16* A1, int lda, int K, const float* W0, const float* W1, int ldw, int N, const Epi& epi) {
    LAS float* L0 = (LAS float*)F.lds;
    const bool sameA = (A1 == A0) || (NMAT == 1);
    LAS float* L1 = sameA ? L0 : L0 + (size_t)K * R;
    for (int rb = F.bid; rb < M / R; rb += F.G) {
        const int r0 = rb * R;
        for (int i = F.tid; i < R * K; i += NTHR) { const int r = i / K, k = i % K; L0[k * R + r] = bf2f(A0[(size_t)(r0 + r) * lda + k]); }
        if (!sameA) for (int i = F.tid; i < R * K; i += NTHR) { const int r = i / K, k = i % K; L1[k * R + r] = bf2f(A1[(size_t)(r0 + r) * lda + k]); }
        __syncthreads();
        for (int n = F.tid; n < N; n += NTHR) {
            float acc0[R], acc1[R];
#pragma unroll
            for (int r = 0; r < R; ++r) { acc0[r] = 0.f; acc1[r] = 0.f; }
#pragma unroll 4
            for (int k = 0; k < K; ++k) {
                const float w0 = W0[(size_t)k * ldw + n];
                float w1 = 0.f; if (NMAT == 2) w1 = W1[(size_t)k * ldw + n];
#pragma unroll
                for (int r4 = 0; r4 < R / 4; ++r4) {
                    const f32x4 a = *(const LAS f32x4*)(L0 + k * R + 4 * r4);
                    acc0[4 * r4 + 0] += a.x * w0; acc0[4 * r4 + 1] += a.y * w0; acc0[4 * r4 + 2] += a.z * w0; acc0[4 * r4 + 3] += a.w * w0;
                    if (NMAT == 2) { const f32x4 a1 = *(const LAS f32x4*)(L1 + k * R + 4 * r4);
                        acc1[4 * r4 + 0] += a1.x * w1; acc1[4 * r4 + 1] += a1.y * w1; acc1[4 * r4 + 2] += a1.z * w1; acc1[4 * r4 + 3] += a1.w * w1; }
                }
            }
#pragma unroll
            for (int r = 0; r < R; ++r) epi(r0 + r, n, acc0[r], acc1[r]);
        }
        __syncthreads();
    }
}

__device__ __forceinline__ void ph_mla_prep(Frame& F) {
    constexpr int R = 16;
    LAS float* A = (LAS float*)F.lds;
    LAS float* SC = A + 384 * R;
    LAS float* OUT = SC + 64;
    for (int rb = F.bid; rb < M / R; rb += F.G) {
        const int r0 = rb * R;
        for (int i = F.tid; i < R * QLORA; i += NTHR) { const int r = i / QLORA, k = i % QLORA; A[k * R + r] = bf2f(F_ZA[(size_t)(r0 + r) * ZA_LD + k]); }
        __syncthreads();
        if (F.tid < R) { float ss = 0.f; for (int k = 0; k < QLORA; ++k) { const float v = A[k * R + F.tid]; ss += v * v; } SC[F.tid] = 1.f / sqrtf(ss * (1.f / QLORA) + EPS); }
        __syncthreads();
        for (int i = F.tid; i < R * QLORA; i += NTHR) { const int r = i % R, k = i / R; A[k * R + r] *= SC[r] * F_q_norm[k]; }
        __syncthreads();
        for (int n = F.tid; n < MLA_H * MLA_QK; n += NTHR) {
            float acc[R];
#pragma unroll
            for (int r = 0; r < R; ++r) acc[r] = 0.f;
#pragma unroll 4
            for (int k = 0; k < QLORA; ++k) { const float w = F_w_uq[(size_t)k * (MLA_H * MLA_QK) + n];
#pragma unroll
                for (int r4 = 0; r4 < R / 4; ++r4) { const f32x4 a = *(const LAS f32x4*)(A + k * R + 4 * r4);
                    acc[4 * r4] += a.x * w; acc[4 * r4 + 1] += a.y * w; acc[4 * r4 + 2] += a.z * w; acc[4 * r4 + 3] += a.w * w; } }
#pragma unroll
            for (int r = 0; r < R; ++r) OUT[r * 1024 + n] = acc[r];
        }
        __syncthreads();
        if (F.tid < R * MLA_H) {
            const int r = F.tid / MLA_H, h = F.tid % MLA_H, row = r0 + r;
            const LAS float* q = OUT + r * 1024 + h * MLA_QK;
            float ss = 0.f; for (int d = 0; d < MLA_QK; ++d) ss += q[d] * q[d];
            const float s = 1.f / sqrtf(ss * (1.f / MLA_QK) + EPS) * C2_MLA;
            bf16* dst = F_QM + (size_t)row * 768 + h * MLA_QK;
            for (int d = 0; d < MLA_NOPE; ++d) dst[d] = f2bf(q[d] * s * F_q_gain[d]);
            const float p = (float)F_pos[row];
            for (int i = 0; i < 16; ++i) {
                const float freq = exp2f(-13.287712379549449f * (float)i * (1.f / 16.f));
                float sn, cs; sincos_red(p * freq, sn, cs);
                const float x1 = q[64 + i] * s * F_q_gain[64 + i], x2 = q[80 + i] * s * F_q_gain[80 + i];
                dst[64 + i] = f2bf(x1 * cs - x2 * sn); dst[80 + i] = f2bf(x2 * cs + x1 * sn);
            }
        }
        __syncthreads();
        for (int i = F.tid; i < R * KVLORA; i += NTHR) { const int r = i / KVLORA, k = i % KVLORA; A[k * R + r] = bf2f(F_ZA[(size_t)(r0 + r) * ZA_LD + QLORA + k]); }
        __syncthreads();
        if (F.tid < R) { float ss = 0.f; for (int k = 0; k < KVLORA; ++k) { const float v = A[k * R + F.tid]; ss += v * v; } SC[F.tid] = 1.f / sqrtf(ss * (1.f / KVLORA) + EPS); }
        __syncthreads();
        for (int i = F.tid; i < R * KVLORA; i += NTHR) { const int r = i % R, k = i / R; A[k * R + r] *= SC[r] * F_kv_norm[k]; }
        __syncthreads();
        for (int n = F.tid; n < 1024; n += NTHR) {
            float acc[R];
#pragma unroll
            for (int r = 0; r < R; ++r) acc[r] = 0.f;
#pragma unroll 4
            for (int k = 0; k < KVLORA; ++k) { const float w = F_w_ukv[(size_t)k * 1024 + n];
#pragma unroll
                for (int r4 = 0; r4 < R / 4; ++r4) { const f32x4 a = *(const LAS f32x4*)(A + k * R + 4 * r4);
                    acc[4 * r4] += a.x * w; acc[4 * r4 + 1] += a.y * w; acc[4 * r4 + 2] += a.z * w; acc[4 * r4 + 3] += a.w * w; } }
#pragma unroll
            for (int r = 0; r < R; ++r) OUT[r * 1024 + n] = acc[r];
        }
        __syncthreads();
        if (F.tid < R * MLA_H) {
            const int r = F.tid / MLA_H, h = F.tid % MLA_H, row = r0 + r;
            const LAS float* kn = OUT + r * 1024 + h * 128;
            const bf16* kr = F_ZA + (size_t)row * ZA_LD + QLORA + KVLORA;
            float ss = 0.f; for (int d = 0; d < 64; ++d) ss += kn[d] * kn[d];
            for (int d = 0; d < 32; ++d) { const float v = bf2f(kr[d]); ss += v * v; }
            const float s = 1.f / sqrtf(ss * (1.f / MLA_QK) + EPS);
            bf16* dk = F_KM + (size_t)row * 768 + h * MLA_QK;
            for (int d = 0; d < 64; ++d) dk[d] = f2bf(kn[d] * s * F_k_gain[d]);
            const float p = (float)F_pos[row];
            for (int i = 0; i < 16; ++i) {
                const float freq = exp2f(-13.287712379549449f * (float)i * (1.f / 16.f));
                float sn, cs; sincos_red(p * freq, sn, cs);
                const float x1 = bf2f(kr[i]) * s * F_k_gain[64 + i], x2 = bf2f(kr[16 + i]) * s * F_k_gain[80 + i];
                dk[64 + i] = f2bf(x1 * cs - x2 * sn); dk[80 + i] = f2bf(x2 * cs + x1 * sn);
            }
            bf16* dv = F_VM + (size_t)row * 512 + h * 64;
            for (int d = 0; d < 64; ++d) dv[d] = f2bf(kn[64 + d]);
        }
        __syncthreads();
    }
}
__device__ __forceinline__ void ph_diff_prep(Frame& F) {
    const int gt = F.bid * NTHR + F.tid, NGT = F.G * NTHR;
    for (int it = gt; it < M * 16; it += NGT) {
        const int row = it >> 4, ch = it & 15;
        bf16* p = F_ZB + (size_t)row * ZB_LD + ch * 64;
        const bool isq = ch < 8;
        const float* gain = isq ? F_dq_gain : F_dk_gain;
        float ss = 0.f;
        for (int d = 0; d < 64; ++d) { const float v = bf2f(p[d]); ss += v * v; }
        const float s = 1.f / sqrtf(ss * (1.f / 64.f) + EPS) * (isq ? C2_DF : 1.f);
        const float ps = (float)F_pos[row];
        float o1[8], o2[8];
#pragma unroll
        for (int i = 0; i < 8; ++i) {
            const float freq = exp2f(-18.931568569324174f * (float)i * (1.f / 8.f));
            float sn, cs; sincos_red(ps * freq, sn, cs);
            const float x1 = bf2f(p[i]) * s * gain[i], x2 = bf2f(p[8 + i]) * s * gain[8 + i];
            o1[i] = x1 * cs - x2 * sn; o2[i] = x2 * cs + x1 * sn;
        }
        for (int d = 16; d < 64; ++d) p[d] = f2bf(bf2f(p[d]) * s * gain[d]);
#pragma unroll
        for (int i = 0; i < 8; ++i) { p[i] = f2bf(o1[i]); p[8 + i] = f2bf(o2[i]); }
    }
}

constexpr int TK = 16;
template <int DQK, int DV>
__device__ __forceinline__ void attn_sweep(Frame& F, const float (&q)[DQK / 4], float (&o)[DV / 4], float& m, float& l, const bf16* Kb, int ldk, const bf16* Vb, int ldv) {
    constexpr int QP = DQK / 4, VP = DV / 4;
    const int part = F.tid & 3;
    LAS float* KL = (LAS float*)F.lds;
    LAS float* VL = KL + TK * DQK;
    for (int t0 = 0; t0 < SEQ; t0 += TK) {
        __syncthreads();
        for (int i = F.tid; i < TK * DQK; i += NTHR) { const int j = i / DQK, d = i % DQK; KL[i] = bf2f(Kb[(size_t)(t0 + j) * ldk + d]); }
        for (int i = F.tid; i < TK * DV; i += NTHR) { const int j = i / DV, d = i % DV; VL[i] = bf2f(Vb[(size_t)(t0 + j) * ldv + d]); }
        __syncthreads();
#pragma unroll 2
        for (int j = 0; j < TK; ++j) {
            float a = 0.f;
#pragma unroll
            for (int d4 = 0; d4 < QP / 4; ++d4) { const f32x4 kv = *(const LAS f32x4*)(KL + j * DQK + part * QP + 4 * d4);
                a += q[4 * d4] * kv.x + q[4 * d4 + 1] * kv.y + q[4 * d4 + 2] * kv.z + q[4 * d4 + 3] * kv.w; }
            a += __shfl_xor(a, 1); a += __shfl_xor(a, 2);
            const float mn = fmaxf(m, a), alpha = exp2f(m - mn), p = exp2f(a - mn);
            l = l * alpha + p; m = mn;
#pragma unroll
            for (int d4 = 0; d4 < VP / 4; ++d4) { const f32x4 vv = *(const LAS f32x4*)(VL + j * DV + part * VP + 4 * d4);
                o[4 * d4] = o[4 * d4] * alpha + p * vv.x; o[4 * d4 + 1] = o[4 * d4 + 1] * alpha + p * vv.y;
                o[4 * d4 + 2] = o[4 * d4 + 2] * alpha + p * vv.z; o[4 * d4 + 3] = o[4 * d4 + 3] * alpha + p * vv.w; }
        }
    }
}
__device__ __forceinline__ void ph_attention(Frame& F) {
    const int part = F.tid & 3, qi = F.tid >> 2;
    for (int u = F.bid; u < 1536; u += F.G) {
        if (u < 1024) {
            const int b = u >> 7, h = (u >> 4) & 7, qc = u & 15;
            const int row = b * SEQ + qc * 128 + qi;
            float q[MLA_QK / 4], o[MLA_V / 4]; float m = -INFINITY, l = 0.f;
#pragma unroll
            for (int d = 0; d < MLA_QK / 4; ++d) q[d] = bf2f(F_QM[(size_t)row * 768 + h * MLA_QK + part * (MLA_QK / 4) + d]);
#pragma unroll
            for (int d = 0; d < MLA_V / 4; ++d) o[d] = 0.f;
            attn_sweep<MLA_QK, MLA_V>(F, q, o, m, l, F_KM + (size_t)b * SEQ * 768 + h * MLA_QK, 768, F_VM + (size_t)b * SEQ * 512 + h * 64, 512);
            const float il = 1.f / l;
#pragma unroll
            for (int d = 0; d < MLA_V / 4; ++d) F_OMD[(size_t)row * 1024 + h * 64 + part * (MLA_V / 4) + d] = f2bf(o[d] * il);
        } else {
            const int v = u - 1024, b = v >> 6, h = (v >> 4) & 3, qc = v & 15;
            const int row = b * SEQ + qc * 128 + qi;
            float lam;
            { float s1 = 0.f, s2 = 0.f; for (int d = 0; d < 64; ++d) { s1 += F_lq1[d] * F_lk1[d]; s2 += F_lq2[d] * F_lk2[d]; } lam = expf(s1) - expf(s2) + LAMBDA_INIT; }
            float q[DF_D / 4], o1[DF_V / 4], o[DF_V / 4];
            const bf16* Zb = F_ZB + (size_t)b * SEQ * ZB_LD;
            { float m = -INFINITY, l = 0.f;
#pragma unroll
              for (int d = 0; d < DF_D / 4; ++d) q[d] = bf2f(F_ZB[(size_t)row * ZB_LD + h * 128 + part * (DF_D / 4) + d]);
#pragma unroll
              for (int d = 0; d < DF_V / 4; ++d) o[d] = 0.f;
              attn_sweep<DF_D, DF_V>(F, q, o, m, l, Zb + 512 + h * 128, ZB_LD, Zb + 1024 + h * 128, ZB_LD);
              const float il = 1.f / l;
#pragma unroll
              for (int d = 0; d < DF_V / 4; ++d) o1[d] = o[d] * il; }
            { float m = -INFINITY, l = 0.f;
#pragma unroll
              for (int d = 0; d < DF_D / 4; ++d) q[d] = bf2f(F_ZB[(size_t)row * ZB_LD + h * 128 + 64 + part * (DF_D / 4) + d]);
#pragma unroll
              for (int d = 0; d < DF_V / 4; ++d) o[d] = 0.f;
              attn_sweep<DF_D, DF_V>(F, q, o, m, l, Zb + 512 + h * 128 + 64, ZB_LD, Zb + 1024 + h * 128, ZB_LD);
              const float il = lam / l;
#pragma unroll
              for (int d = 0; d < DF_V / 4; ++d) F_OMD[(size_t)row * 1024 + 512 + h * 128 + part * (DF_V / 4) + d] = f2bf(o1[d] - o[d] * il); }
        }
    }
}

#define ATT_LANE() int t_ = threadIdx.x; asm volatile("" : "+v"(t_)); const int wid = __builtin_amdgcn_readfirstlane(t_ >> 6), r32 = t_ & 31, hi = (t_ >> 5) & 1
__device__ __forceinline__ void ph_attention_mfma(Frame& F) {
    using namespace attn;
    const int vcu = (F.G % 8 == 0) ? (F.bid % 8) * (F.G / 8) + F.bid / 8 : F.bid;
    LAS char* lds = (LAS char*)F.lds;
    for (int it = vcu; it < 768; it += F.G) {
        if (it < 512) {
            const int bh = it >> 3, qb = it & 7, b = bh >> 3, h = bh & 7;
            const size_t row0 = (size_t)b * SEQ + qb * 256;
            f32x16 o[2]; float l;
            sweep<MLA_QK, MLA_V>(F_QM + row0 * 768 + h * MLA_QK, 768, F_KM + (size_t)b * SEQ * 768 + h * MLA_QK, 768, F_VM + (size_t)b * SEQ * 512 + h * MLA_V, 512, o, l, lds);
            ATT_LANE();
            float rli[16]; row_recip(l, rli, lds, wid, r32, hi);
            bf16* Ow = F_OMD + (row0 + wid * QBLK) * 1024 + h * MLA_V;
#pragma unroll
            for (int r = 0; r < 16; ++r) { const int orow = crow(r, hi);
#pragma unroll
                for (int d0 = 0; d0 < 2; ++d0) Ow[(size_t)orow * 1024 + d0 * 32 + r32] = f2bf(o[d0][r] * rli[r]); }
        } else {
            const int v = it - 512, bh = v >> 3, qb = v & 7, b = bh >> 2, h = bh & 3;
            const size_t row0 = (size_t)b * SEQ + qb * 256;
            f32x16 o[4]; float l;
            { const bf16* Zb = F_ZB + (size_t)b * SEQ * ZB_LD;
              sweep<DF_D, DF_V>(F_ZB + row0 * ZB_LD + h * 128, ZB_LD, Zb + 512 + h * 128, ZB_LD, Zb + 1024 + h * 128, ZB_LD, o, l, lds); }
            { ATT_LANE();
              bf16* Ow = F_OMD + (row0 + wid * QBLK) * 1024 + 512 + h * DF_V;
              float rli[16]; row_recip(l, rli, lds, wid, r32, hi);
#pragma unroll
              for (int r = 0; r < 16; ++r) { const int orow = crow(r, hi);
#pragma unroll
                  for (int d0 = 0; d0 < 4; ++d0) Ow[(size_t)orow * 1024 + d0 * 32 + r32] = f2bf(o[d0][r] * rli[r]); } }
            asm volatile("" ::: "memory");
            { const bf16* Zb = F_ZB + (size_t)b * SEQ * ZB_LD;
              sweep<DF_D, DF_V>(F_ZB + row0 * ZB_LD + h * 128 + 64, ZB_LD, Zb + 512 + h * 128 + 64, ZB_LD, Zb + 1024 + h * 128, ZB_LD, o, l, lds); }
            ATT_LANE();
            bf16* Ow = F_OMD + (row0 + wid * QBLK) * 1024 + 512 + h * DF_V;
            float lam;
            { float s1 = 0.f, s2 = 0.f; for (int d = 0; d < 64; ++d) { s1 += F_lq1[d] * F_lk1[d]; s2 += F_lq2[d] * F_lk2[d]; } lam = expf(s1) - expf(s2) + LAMBDA_INIT; }
            float rli[16]; row_recip(l, rli, lds, wid, r32, hi);
            float ss[16];
#pragma unroll
            for (int r = 0; r < 16; ++r) { const int orow = crow(r, hi); float s = 0.f; const float f = lam * rli[r];
#pragma unroll
                for (int d0 = 0; d0 < 4; ++d0) { const float dv = bf2f(Ow[(size_t)orow * 1024 + d0 * 32 + r32]) - o[d0][r] * f; o[d0][r] = dv; s += dv * dv; }
                ss[r] = s; }
#pragma unroll
            for (int r = 0; r < 16; ++r) { float s = ss[r];
                s += __shfl_xor(s, 1); s += __shfl_xor(s, 2); s += __shfl_xor(s, 4); s += __shfl_xor(s, 8); s += __shfl_xor(s, 16);
                ss[r] = 1.f / sqrtf(s * (1.f / 128.f) + EPS) * (1.f - LAMBDA_INIT); }
            float gsub[4];
#pragma unroll
            for (int d0 = 0; d0 < 4; ++d0) gsub[d0] = F_subln[d0 * 32 + r32];
#pragma unroll
            for (int r = 0; r < 16; ++r) { const int orow = crow(r, hi);
#pragma unroll
                for (int d0 = 0; d0 < 4; ++d0) Ow[(size_t)orow * 1024 + d0 * 32 + r32] = f2bf(o[d0][r] * ss[r] * gsub[d0]); }
        }
    }
}
__device__ __forceinline__ void ph_subln(Frame& F) {
    const int gt = F.bid * NTHR + F.tid, NGT = F.G * NTHR;
    for (int it = gt; it < M * 4; it += NGT) {
        bf16* p = F_OMD + (size_t)(it >> 2) * 1024 + 512 + (it & 3) * 128;
        float ss = 0.f;
        for (int d = 0; d < 128; ++d) { const float v = bf2f(p[d]); ss += v * v; }
        const float s = 1.f / sqrtf(ss * (1.f / 128.f) + EPS) * (1.f - LAMBDA_INIT);
        for (int d = 0; d < 128; ++d) p[d] = f2bf(bf2f(p[d]) * s * F_subln[d]);
    }
}

struct NEpiSwiglu { bf16* ACT; __device__ __forceinline__ void operator()(int row, int col, float g, float u) const { ACT[(size_t)row * DFF + col] = f2bf(silu_f(g) * u); } };
struct NEpiResid { float* H; const float* base; const float* MOD; int gt_off; float scale;
    __device__ __forceinline__ void operator()(int row, int col, float a, float) const { const int b = row / SEQ; H[(size_t)row * D + col] = base[(size_t)row * D + col] + scale * MOD[b * ADA + gt_off + col] * a; } };
struct NEpiZ { bf16 *ZA, *ZB, *ZG;
    __device__ __forceinline__ void operator()(int row, int col, float a, float) const {
        if (col < 672) ZA[(size_t)row * ZA_LD + col] = f2bf(a);
        else if (col < 2208) ZB[(size_t)row * ZB_LD + (col - 672)] = f2bf(a);
        else ZG[(size_t)row * ZG_LD + (col - 2208)] = f2bf(a); } };
struct NEpiMerge { bf16* MRG; const bf16* ZG;
    __device__ __forceinline__ void operator()(int row, int col, float ya, float yb) const {
        const float ga = sigmoid_f(bf2f(ZG[(size_t)row * ZG_LD + col])), gb = sigmoid_f(bf2f(ZG[(size_t)row * ZG_LD + 1024 + col]));
        MRG[(size_t)row * D + col] = f2bf(ga * ya + gb * yb); } };

constexpr int NPH = 15;

__global__ void __launch_bounds__(NTHR, 2) mk_fwd(Args args) {
    extern __shared__ __attribute__((aligned(16))) unsigned char lds_raw[];
    Frame F;
    F.lds = (LAS unsigned char*)lds_raw;
    F.tid = threadIdx.x; F.lane = F.tid & 63; F.wave = __builtin_amdgcn_readfirstlane(F.tid >> 6); F.G = gridDim.x; F.bid = blockIdx.x;
    unsigned char* ws = args.ws;
    F.in = args.in; F.ws = args.ws; F.H = args.out;

    for (int u = F.tid; u < (LDS_BYTES - LDSCTL_OFF) / 4; u += NTHR) ((LAS unsigned*)(F.lds + LDSCTL_OFF))[u] = 0u;
    __syncthreads();
    volatile LAS unsigned* MISC = (volatile LAS unsigned*)(F.lds + MISC_OFF);
    const bool multi = (args.ph_hi - args.ph_lo) > 1;
    XcdBarrier bar; bar.bar = (unsigned*)(ws + WS_CTL) + CW_BAR; bar.x = 0; bar.st = MISC + 8;
    if (multi) bar = xcd_barrier_post((unsigned*)(ws + WS_CTL) + CW_BAR, MISC + 8);

    const int lo = args.ph_lo, hi = args.ph_hi;
#define IN(k) (lo <= (k) && (k) < hi)
#define SEAM(k) do { if (IN(k) && IN((k) + 1)) xcd_barrier(bar); } while (0)
    const int gw = F.bid * NWAVES + F.wave, NGW = F.G * NWAVES;
    pg8::bf16_t* const WUP = (pg8::bf16_t*)(ws + WS_WUP); pg8::bf16_t* const WDN = (pg8::bf16_t*)(ws + WS_WDN);
    if (IN(0)) { ph_adaln(F); __syncthreads(); tr_ffn(F, F_ffn1_wg, F_ffn1_wu, F_ffn1_wd, gw, NGW); tr_misc(F, gw, NGW); } SEAM(0);
    if (IN(1)) { ph_norm_mod(F, F_x, F_ffn1_norm, 0 * D, 1 * D, F_XN); } SEAM(1);
    if (IN(2)) { pg8::Gemm g{F_XN, WUP, M, 2 * DFF, D, D, D}; pg8::StaticOrder S; S.init(M, 2 * DFF, F.G, F.bid);
        pg8::EpiSwiglu E{F_ACT, DFF}; pg8::gemm_phase<pg8::EpiSwiglu, pg8::StaticOrder, true, true>(F.lds, g, S, E); } SEAM(2);
    if (IN(3)) { pg8::Gemm g{F_ACT, WDN, M, D, DFF, DFF, DFF}; pg8::StaticOrder S; S.init(M, D, F.G, F.bid);
        pg8::EpiResid E{F_x, F.H, F_MOD + 2 * D, ADA, 0.5f}; pg8::gemm_phase<pg8::EpiResid, pg8::StaticOrder, false, true>(F.lds, g, S, E); } SEAM(3);
    if (IN(4)) { ph_norm_mod(F, F.H, F_mix_norm, 3 * D, 4 * D, F_XN); } SEAM(4);
    if (IN(5)) { pg8::Gemm g{F_XN, (pg8::bf16_t*)(ws + WS_WIN), M, 4352, D, D, D}; pg8::StaticOrder S; S.init(M, 4352, F.G, F.bid);
        pg8::EpiZ E{F_ZA, F_ZB, F_ZG}; pg8::gemm_phase<pg8::EpiZ, pg8::StaticOrder, true, true>(F.lds, g, S, E); } SEAM(5);
    if (IN(6)) { ph_mla_prep(F); ph_diff_prep(F); } SEAM(6);
    if (IN(7)) { ph_attention_mfma(F); } SEAM(7);
    if (IN(8)) { tr_ffn(F, F_ffn2_wg, F_ffn2_wu, F_ffn2_wd, gw, NGW); } SEAM(8);
    if (IN(9)) { pg8::StaticOrder S; S.init(M, D, F.G, F.bid);
        { pg8::Gemm g{F_OMD, (pg8::bf16_t*)(ws + WS_WO), M, D, 512, D, D}; pg8::EpiGate<0> E{F_MRG, F_ZG}; pg8::gemm_phase<pg8::EpiGate<0>, pg8::StaticOrder, false, true>(F.lds, g, S, E); }
        { pg8::Gemm g{F_OMD + 512, (pg8::bf16_t*)(ws + WS_WO) + 512, M, D, 512, D, D}; pg8::EpiGate<1> E{F_MRG, F_ZG}; pg8::gemm_phase<pg8::EpiGate<1>, pg8::StaticOrder, false, true>(F.lds, g, S, E); } } SEAM(9);
    if (IN(10)) { pg8::Gemm g{F_MRG, (pg8::bf16_t*)(ws + WS_WOUT), M, D, D, D, D}; pg8::StaticOrder S; S.init(M, D, F.G, F.bid);
        pg8::EpiResid E{F.H, F.H, F_MOD + 5 * D, ADA, 1.0f}; pg8::gemm_phase<pg8::EpiResid, pg8::StaticOrder, false, true>(F.lds, g, S, E); } SEAM(10);
    if (IN(11)) { ph_norm_mod(F, F.H, F_ffn2_norm, 6 * D, 7 * D, F_XN); } SEAM(11);
    if (IN(12)) { pg8::Gemm g{F_XN, WUP, M, 2 * DFF, D, D, D}; pg8::StaticOrder S; S.init(M, 2 * DFF, F.G, F.bid);
        pg8::EpiSwiglu E{F_ACT, DFF}; pg8::gemm_phase<pg8::EpiSwiglu, pg8::StaticOrder, true, true>(F.lds, g, S, E); } SEAM(12);
    if (IN(13)) { pg8::Gemm g{F_ACT, WDN, M, D, DFF, DFF, DFF}; pg8::StaticOrder S; S.init(M, D, F.G, F.bid);
        pg8::EpiResid E{F.H, F.H, F_MOD + 8 * D, ADA, 0.5f}; pg8::gemm_phase<pg8::EpiResid, pg8::StaticOrder, false, true>(F.lds, g, S, E); } SEAM(13);
    if (IN(14)) { ph_final_norm(F); }
#undef IN
#undef SEAM
}

#ifndef MK_ONE_LAUNCH
#define MK_ONE_LAUNCH 1
#endif

extern "C" void kernel_launch(void* const* d_in, const int* in_sizes, int n_in, void* d_out, int out_size, void* d_ws, size_t ws_size, hipStream_t stream) {
    static int grid = 0;
    if (grid == 0) {
        if (n_in != 32 || in_sizes[0] != M * D || out_size != M * D || ws_size < WS_END) {
            fprintf(stderr, "kernel_launch: unexpected shapes: n_in %d in0 %d out %d ws %zu (need %zu)\n", n_in, n_in > 0 ? in_sizes[0] : -1, out_size, ws_size, (size_t)WS_END); grid = -1; return; }
        int dev = 0, cus = 0, per_cu = 0;
        if (hipGetDevice(&dev) != hipSuccess || hipDeviceGetAttribute(&cus, hipDeviceAttributeMultiprocessorCount, dev) != hipSuccess) { grid = -1; return; }
        if (hipFuncSetAttribute((const void*)mk_fwd, hipFuncAttributeMaxDynamicSharedMemorySize, LDS_BYTES) != hipSuccess) { fprintf(stderr, "kernel_launch: hipFuncSetAttribute failed\n"); grid = -1; return; }
        if (hipOccupancyMaxActiveBlocksPerMultiprocessor(&per_cu, (const void*)mk_fwd, NTHR, LDS_BYTES) != hipSuccess || per_cu < 1) {
            fprintf(stderr, "kernel_launch: occupancy query says %d blocks per CU\n", per_cu); per_cu = 1; }
        (void)hipGetLastError();
        grid = cus;
    }
    if (grid < 0) return;
    if (hipMemsetAsync((char*)d_ws + WS_CTL, 0, CTL_ZERO_BYTES, stream) != hipSuccess) { fprintf(stderr, "kernel_launch: memset failed\n"); return; }
    Args a{};
    for (int i = 0; i < 32; ++i) a.in[i] = d_in[i];
    a.out = (float*)d_out; a.ws = (unsigned char*)d_ws;
#if MK_ONE_LAUNCH
    a.ph_lo = 0; a.ph_hi = NPH;
    hipLaunchKernelGGL(mk_fwd, dim3(grid), dim3(NTHR), LDS_BYTES, stream, a);
#else
    for (int p = 0; p < NPH; ++p) { a.ph_lo = p; a.ph_hi = p + 1; hipLaunchKernelGGL(mk_fwd, dim3(grid), dim3(NTHR), LDS_BYTES, stream, a); }
#endif
    const hipError_t le = hipPeekAtLastError();
    if (le != hipSuccess) fprintf(stderr, "kernel_launch: launch failed: %s\n", hipGetErrorName(le));
}
```

```cpp
#include <hip/hip_runtime.h>
#include <cstdio>
#include <cstdint>

constexpr int BATCH = 8, SEQ = 2048, D = 1024, M = BATCH * SEQ, DFF = 2816, ADA = 9 * D;
constexpr int QLORA = 384, KVLORA = 256, ROPE_A = 32, MLA_H = 8, MLA_QK = 96, MLA_NOPE = 64, MLA_V = 64;
constexpr int DF_H = 4, DF_D = 64, DF_V = 128, ROT = 16;
constexpr int IN_COLS = 4256;
constexpr int ZA_LD = 768, ZB_LD = 1536, ZG_LD = 2048;
constexpr float EPS = 1e-6f;
constexpr float LOG2E = 1.4426950408889634f;
constexpr float C2_MLA = 0.10206207261596577f * LOG2E;
constexpr float C2_DF = 0.125f * LOG2E;
constexpr float LAMBDA_INIT = 0.2f;
constexpr int NWAVES = 8, NTHR = 512;

constexpr size_t MiB = 1u << 20;
constexpr size_t WS_CTL = 0, CTL_ZERO_BYTES = 1 * MiB;
constexpr size_t WS_MOD = 1 * MiB;
constexpr size_t WS_WUP = 2 * MiB;
constexpr size_t WS_WDN = 13 * MiB;
constexpr size_t WS_VM = 2 * MiB;
constexpr size_t WS_WIN = 18 * MiB + 512 * 1024;
constexpr size_t WS_WO = 27 * MiB;
constexpr size_t WS_WOUT = 29 * MiB;
constexpr size_t WS_WUQ = 31 * MiB;
constexpr size_t WS_WUKV = 32 * MiB;
constexpr size_t WS_XN = 33 * MiB;
constexpr size_t WS_OMD = 33 * MiB;
constexpr size_t WS_BIG = 65 * MiB;
constexpr size_t WS_ACT = WS_BIG;
constexpr size_t WS_ZG = WS_BIG;
constexpr size_t WS_ZB = WS_BIG + 64 * MiB;
constexpr size_t WS_ZA = WS_BIG + 112 * MiB;
constexpr size_t WS_QM = WS_BIG + 136 * MiB;
constexpr size_t WS_KM = WS_BIG + 160 * MiB;
constexpr size_t WS_MRG = WS_QM;
constexpr size_t WS_END = WS_BIG + 184 * MiB;
constexpr size_t WS_TABD = 249 * MiB;
constexpr size_t WS_TABM = 250 * MiB;
constexpr size_t WS_KVR = WS_XN;
constexpr size_t WS_TOP = 251 * MiB;
constexpr int CW_BAR = 4096;

constexpr int LDS_BYTES = 147456, RING_BYTES = 131072, LDSCTL_OFF = RING_BYTES, MISC_OFF = LDSCTL_OFF + 320;

#define GAS __attribute__((address_space(1)))
#define LAS __attribute__((address_space(3)))
typedef unsigned short bf16;
typedef float f32x4 __attribute__((ext_vector_type(4)));

__device__ __forceinline__ float bf2f(bf16 v) { return __uint_as_float(((unsigned)v) << 16); }
__device__ __forceinline__ bf16 f2bf(float f) { unsigned u = __float_as_uint(f); return (bf16)((u + 0x7fffu + ((u >> 16) & 1u)) >> 16); }
__device__ __forceinline__ float silu_f(float v) { return v / (1.f + __expf(-v)); }
__device__ __forceinline__ float sigmoid_f(float v) { return 1.f / (1.f + __expf(-v)); }
__device__ __forceinline__ float wave_sum(float v) {
#pragma unroll
    for (int o = 1; o < 64; o <<= 1) v += __shfl_xor(v, o);
    return v;
}
__device__ __forceinline__ void sincos_red(float ang, float& sn, float& cs) {
    double t = (double)ang * 0.15915494309189535;
    t -= __builtin_rint(t);
    const float r = (float)t;
    sn = __builtin_amdgcn_sinf(r); cs = __builtin_amdgcn_cosf(r);
}

#define XB_TMO      128
#define XB_XCNT(j)  (256  + 64 * (j))
#define XB_XSUB(j)  (1280 + 64 * (j))
#define XB_XGEN(j)  (2304 + 64 * (j))
#define XB_TOP      3328
#define XB_TOPGEN   3392
#define XCD_BAR_WORDS 3456
#define XB_SPIN_CAP (1u << 24)
__device__ __forceinline__ unsigned xb_ld(unsigned* p)              { return __hip_atomic_load(p, __ATOMIC_RELAXED, __HIP_MEMORY_SCOPE_AGENT); }
__device__ __forceinline__ unsigned xb_add(unsigned* p, unsigned v) { return __hip_atomic_fetch_add(p, v, __ATOMIC_RELAXED, __HIP_MEMORY_SCOPE_AGENT); }
__device__ __forceinline__ unsigned xb_xcc_id() { return (unsigned)__builtin_amdgcn_s_getreg((3 << 11) | 20) & 0xFu; }
#define XB_SPIN(cond, bar) do { unsigned _sp = 0; while (cond) { __builtin_amdgcn_s_sleep(1); \
    if ((++_sp & 255u) == 0u) { if (xb_ld(&(bar)[XB_TMO])) break; if (_sp > XB_SPIN_CAP) { atomicAdd(&(bar)[XB_TMO], 1u); break; } } } } while (0)
struct XcdBarrier { unsigned* bar; unsigned x; volatile LAS unsigned* st; };
__device__ __forceinline__ XcdBarrier xcd_barrier_post(unsigned* bar, volatile LAS unsigned* st) {
    XcdBarrier b; b.bar = bar; b.x = xb_xcc_id(); b.st = st;
    if (threadIdx.x == 0) (void)xb_add(&bar[XB_XCNT(b.x)], 1u);
    return b;
}
__device__ __forceinline__ void xcd_barrier_complete(unsigned* bar, unsigned x, unsigned& nloc, unsigned& nx) {
    const unsigned G = gridDim.x * gridDim.y * gridDim.z;
    unsigned sum, cnt, mine, sp = 0u;
    for (;;) {
        sum = 0u; cnt = 0u; mine = 0u;
#pragma unroll
        for (unsigned j = 0; j < 16; ++j) { const unsigned c = xb_ld(&bar[XB_XCNT(j)]); sum += c; cnt += (c > 0u) ? 1u : 0u; mine = (j == x) ? c : mine; }
        if (sum == G) break;
        __builtin_amdgcn_s_sleep(1);
        if ((++sp & 255u) == 0u) { if (xb_ld(&bar[XB_TMO])) break; if (sp > XB_SPIN_CAP) { atomicAdd(&bar[XB_TMO], 1u); break; } }
    }
    nloc = mine > 0u ? mine : 1u; nx = cnt > 0u ? cnt : 1u;
}
__device__ __forceinline__ void xcd_barrier(const XcdBarrier& b) {
    asm volatile("s_waitcnt vmcnt(0)" ::: "memory");
    __syncthreads();
    if (threadIdx.x == 0) {
        unsigned* bar = b.bar;
        __builtin_amdgcn_s_waitcnt(0);
        unsigned nloc = b.st[0], nx = b.st[1];
        if (nloc == 0u) { xcd_barrier_complete(bar, b.x, nloc, nx); b.st[0] = nloc; b.st[1] = nx; }
        const unsigned old = xb_add(&bar[XB_XSUB(b.x)], 1u);
        const unsigned gen = old / nloc;
        if (old + 1u == (gen + 1u) * nloc) {
            __builtin_amdgcn_fence(__ATOMIC_RELEASE, "agent");
            asm volatile("s_waitcnt vmcnt(0)" ::: "memory");
            const unsigned og = xb_add(&bar[XB_TOP], 1u);
            const unsigned tg = og / nx;
            if (og + 1u == (tg + 1u) * nx) xb_add(&bar[XB_TOPGEN], 1u);
            else XB_SPIN(xb_ld(&bar[XB_TOPGEN]) == tg, bar);
            __builtin_amdgcn_fence(__ATOMIC_ACQUIRE, "agent");
            xb_add(&bar[XB_XGEN(b.x)], 1u);
            asm volatile("s_waitcnt vmcnt(0)" ::: "memory");
        } else {
            XB_SPIN(xb_ld(&bar[XB_XGEN(b.x)]) == gen, bar);
            __builtin_amdgcn_fence(__ATOMIC_ACQUIRE, "agent");
            asm volatile("s_waitcnt vmcnt(0)" ::: "memory");
        }
    }
    __syncthreads();
}

namespace pg8 {
#define PG8_LAS __attribute__((address_space(3)))
typedef unsigned short bf16_t;
typedef short bf16x8 __attribute__((ext_vector_type(8)));
typedef float f32x4 __attribute__((ext_vector_type(4)));
typedef unsigned u32x4 __attribute__((ext_vector_type(4)));
constexpr int BM = 256, BK = 64, HALF = 128, HTB = HALF * BK * 2  , STAGE_BYTES = 8 * HTB, NXCD = 8, WGM = 8;

__host__ __device__ __forceinline__ int lds_byte(int r, int c) { const int st = (r >> 4) * 2 + (c >> 5), rr = r & 15, cc = c & 31, ob = rr * 64 + cc * 2; return st * 1024 + (ob ^ (((ob >> 9) & 1) << 5)); }
__host__ __device__ __forceinline__ void stage_rc(int b, int& R, int& C) { const int st = b / 1024, sb = b % 1024, swz = sb ^ (((sb >> 9) & 1) << 5); R = (st >> 1) * 16 + swz / 64; C = (st & 1) * 32 + (swz % 64) / 2; }
__host__ __device__ __forceinline__ int perm32(int rho) { const int n = rho >> 4, i = rho & 15; return 8 * (i >> 2) + 4 * n + (i & 3); }

struct Unit { int pm, pn; };
struct Gemm { const bf16_t* A; const bf16_t* Bt; int M, N, K, lda, ldb; };

struct StaticOrder {
    int nM, nN, nwg, G, c;
    __host__ __device__ void init(int M, int N, int G_, int c_) { nM = M / BM; nN = N / BM; nwg = nM * nN; G = G_; c = c_; }
    __host__ __device__ bool next(int i, Unit& u) const {
        const long L = (long)i * G + c; if (L >= nwg) return false;
        int wgid = (int)L; { const int q = nwg / NXCD, r = nwg % NXCD, xcd = wgid % NXCD, off = wgid / NXCD; wgid = (xcd < r ? xcd * (q + 1) : r * (q + 1) + (xcd - r) * q) + off; }
        const int nig = WGM * nN, gid = wgid / nig, fm = gid * WGM, gsz = (nM - fm) < WGM ? (nM - fm) : WGM;
        u.pm = fm + ((wgid % nig) % gsz); u.pn = (wgid % nig) / gsz; return true;
    }
    __device__ __forceinline__ void a_ready(const Unit&) const {}
    __device__ __forceinline__ void done(const Unit&) const {}
};
__device__ __forceinline__ unsigned cvt_pk_bf16(float lo, float hi) { unsigned r; asm volatile("v_cvt_pk_bf16_f32 %0, %1, %2" : "=v"(r) : "v"(lo), "v"(hi)); return r; }
typedef float f32x2 __attribute__((ext_vector_type(2)));

__device__ __forceinline__ float fast_sigmoid(float v) { return __builtin_amdgcn_rcpf(1.0f + __builtin_amdgcn_exp2f(-1.4426950408889634f * v)); }
struct EpiSwiglu {
    static constexpr bool PERM = true, AFTER_DRAIN = false;
    bf16_t* O; int ldc;
    __device__ __forceinline__ void operator()(const f32x4 (&acc)[2][2][4][2], const Unit& u, int wr, int wc, int fr, int fq) const {
        const int row0 = u.pm * BM + wr * 64 + fr, col0 = u.pn * HALF + wc * 32 + 8 * fq;
#pragma unroll
        for (int ai = 0; ai < 2; ++ai)
#pragma unroll
            for (int m = 0; m < 4; ++m) { bf16_t* rowp = O + (size_t)(row0 + ai * HALF + m * 16) * ldc + col0;
                float v[8];
#pragma unroll
                for (int n = 0; n < 2; ++n)
#pragma unroll
                    for (int j = 0; j < 4; ++j) { const float g = acc[ai][0][m][n][j], up = acc[ai][1][m][n][j]; v[4 * n + j] = g * fast_sigmoid(g) * up; }
                u32x4 w; w.x = cvt_pk_bf16(v[0], v[1]); w.y = cvt_pk_bf16(v[2], v[3]); w.z = cvt_pk_bf16(v[4], v[5]); w.w = cvt_pk_bf16(v[6], v[7]);
                *(u32x4*)rowp = w; }
    }
};
struct EpiResid {
    static constexpr bool PERM = false, AFTER_DRAIN = false;
    const float* base; float* out; const float* gt; int gstride; float scale;
    __device__ __forceinline__ void operator()(const f32x4 (&acc)[2][2][4][2], const Unit& u, int wr, int wc, int fr, int fq) const {
        const int row0 = u.pm * BM + wr * 64 + fr, col0 = u.pn * BM + wc * 32 + 4 * fq;
        const float* gp = gt + (size_t)(u.pm >> 3) * gstride + col0;
        f32x4 gv[2][2];
#pragma unroll
        for (int bj = 0; bj < 2; ++bj)
#pragma unroll
            for (int n = 0; n < 2; ++n) gv[bj][n] = *(const f32x4*)(gp + bj * HALF + n * 16) * scale;
#pragma unroll
        for (int ai = 0; ai < 2; ++ai)
#pragma unroll
            for (int m = 0; m < 4; ++m) { const size_t off = (size_t)(row0 + ai * HALF + m * 16) * 1024 + col0;
#pragma unroll
                for (int bj = 0; bj < 2; ++bj)
#pragma unroll
                    for (int n = 0; n < 2; ++n) { const f32x4 bs = *(const f32x4*)(base + off + bj * HALF + n * 16);
                        *(f32x4*)(out + off + bj * HALF + n * 16) = bs + gv[bj][n] * acc[ai][bj][m][n]; } }
    }
};
struct EpiPlain {
    static constexpr bool PERM = true, AFTER_DRAIN = false;
    bf16_t* O; int ldc;
    __device__ __forceinline__ void operator()(const f32x4 (&acc)[2][2][4][2], const Unit& u, int wr, int wc, int fr, int fq) const {
        const int row0 = u.pm * BM + wr * 64 + fr, col0 = u.pn * BM + wc * 32 + 8 * fq;
#pragma unroll
        for (int ai = 0; ai < 2; ++ai)
#pragma unroll
            for (int m = 0; m < 4; ++m) { bf16_t* rowp = O + (size_t)(row0 + ai * HALF + m * 16) * ldc + col0;
#pragma unroll
                for (int bj = 0; bj < 2; ++bj) { const f32x4 v0 = acc[ai][bj][m][0], v1 = acc[ai][bj][m][1];
                    u32x4 w; w.x = cvt_pk_bf16(v0[0], v0[1]); w.y = cvt_pk_bf16(v0[2], v0[3]); w.z = cvt_pk_bf16(v1[0], v1[1]); w.w = cvt_pk_bf16(v1[2], v1[3]);
                    *(u32x4*)(rowp + bj * HALF) = w; } }
    }
};
struct EpiZ {
    static constexpr bool PERM = true, AFTER_DRAIN = false;
    bf16_t *ZA, *ZB, *ZG; const float *qgain, *kgain; const int* pos; const float* tab;
    float qscale, eps;
    __device__ __forceinline__ void operator()(const f32x4 (&acc)[2][2][4][2], const Unit& u, int wr, int wc, int fr, int fq) const {
        if (u.pn >= 3 && u.pn < 7) {
            const bool isq = u.pn < 5; const float* gain = isq ? qgain : kgain; const float sc0 = isq ? qscale : 1.0f;
            const int row0 = u.pm * BM + wr * 64 + fr, ccol = (u.pn - 3) * BM + wc * 64;
            f32x4 gv[2][2];
#pragma unroll
            for (int bj = 0; bj < 2; ++bj)
#pragma unroll
                for (int n = 0; n < 2; ++n) gv[bj][n] = *(const f32x4*)(gain + bj * 32 + 8 * fq + 4 * n);
#pragma unroll
            for (int ai = 0; ai < 2; ++ai)
#pragma unroll
                for (int m = 0; m < 4; ++m) { const int row = row0 + ai * HALF + m * 16;
                    float ss = 0.f;
#pragma unroll
                    for (int bj = 0; bj < 2; ++bj)
#pragma unroll
                        for (int n = 0; n < 2; ++n) { const f32x4 x = acc[ai][bj][m][n]; ss += (x[0] * x[0] + x[1] * x[1]) + (x[2] * x[2] + x[3] * x[3]); }
                    ss += __shfl_xor(ss, 16); ss += __shfl_xor(ss, 32);
                    const float s = sc0 / sqrtf(ss * (1.0f / 64.0f) + eps);
                    f32x4 y[2][2];
#pragma unroll
                    for (int bj = 0; bj < 2; ++bj)
#pragma unroll
                        for (int n = 0; n < 2; ++n) y[bj][n] = acc[ai][bj][m][n] * s * gv[bj][n];
                    const int p = pos[row];
                    const float* tp = tab + (size_t)p * 16;
#pragma unroll
                    for (int n = 0; n < 2; ++n) { const f32x4 cs0 = *(const f32x4*)(tp + 8 * n), cs1 = *(const f32x4*)(tp + 8 * n + 4);
                        f32x4 o;
#pragma unroll
                        for (int j = 0; j < 4; ++j) { const float own = y[0][n][j], oth = __shfl_xor(own, 16);
                            const float c = (j < 2) ? cs0[2 * j] : cs1[2 * (j - 2)], sn = (j < 2) ? cs0[2 * j + 1] : cs1[2 * (j - 2) + 1];
                            o[j] = (fq == 0) ? own * c - oth * sn : own * c + oth * sn; }
                        if (fq < 2) y[0][n] = o; }
                    bf16_t* rowp = ZB + (size_t)row * 1536 + ccol + 8 * fq;
#pragma unroll
                    for (int bj = 0; bj < 2; ++bj) { u32x4 w; w.x = cvt_pk_bf16(y[bj][0][0], y[bj][0][1]); w.y = cvt_pk_bf16(y[bj][0][2], y[bj][0][3]); w.z = cvt_pk_bf16(y[bj][1][0], y[bj][1][1]); w.w = cvt_pk_bf16(y[bj][1][2], y[bj][1][3]);
                        *(u32x4*)(rowp + bj * 32) = w; } }
            return;
        }
        bf16_t* base; int ldc, ct;
        if (u.pn < 3) { base = ZA; ldc = 768; ct = u.pn; } else if (u.pn < 9) { base = ZB; ldc = 1536; ct = u.pn - 3; } else { base = ZG; ldc = 2048; ct = u.pn - 9; }
        const int row0 = u.pm * BM + wr * 64 + fr, col0 = ct * BM + wc * 32 + 8 * fq;
#pragma unroll
        for (int ai = 0; ai < 2; ++ai)
#pragma unroll
            for (int m = 0; m < 4; ++m) { bf16_t* rowp = base + (size_t)(row0 + ai * HALF + m * 16) * ldc + col0;
#pragma unroll
                for (int bj = 0; bj < 2; ++bj) { const f32x4 v0 = acc[ai][bj][m][0], v1 = acc[ai][bj][m][1];
                    u32x4 w; w.x = cvt_pk_bf16(v0[0], v0[1]); w.y = cvt_pk_bf16(v0[2], v0[3]); w.z = cvt_pk_bf16(v1[0], v1[1]); w.w = cvt_pk_bf16(v1[2], v1[3]);
                    *(u32x4*)(rowp + bj * HALF) = w; } }
    }
};
template <int PASS> struct EpiGate {
    static constexpr bool PERM = true, AFTER_DRAIN = false;
    bf16_t* O; const bf16_t* ZG;
    __device__ __forceinline__ void operator()(const f32x4 (&acc)[2][2][4][2], const Unit& u, int wr, int wc, int fr, int fq) const {
        const int row0 = u.pm * BM + wr * 64 + fr, col0 = u.pn * BM + wc * 32 + 8 * fq;
#pragma unroll
        for (int ai = 0; ai < 2; ++ai)
#pragma unroll
            for (int m = 0; m < 4; ++m) { const size_t r = (size_t)(row0 + ai * HALF + m * 16);
#pragma unroll
                for (int bj = 0; bj < 2; ++bj) {
                    const u32x4 gl = *(const u32x4*)(ZG + r * 2048 + PASS * 1024 + col0 + bj * HALF);
                    u32x4 prev = (u32x4){0u, 0u, 0u, 0u}; if (PASS == 1) prev = *(const u32x4*)(O + r * 1024 + col0 + bj * HALF);
                    float v[8];
#pragma unroll
                    for (int q = 0; q < 4; ++q) { const unsigned gw = gl[q], pw = prev[q];
                        const float g0 = __uint_as_float(gw << 16), g1 = __uint_as_float(gw & 0xffff0000u);
                        const float p0 = __uint_as_float(pw << 16), p1 = __uint_as_float(pw & 0xffff0000u);
                        const float a0 = acc[ai][bj][m][q >> 1][(q & 1) * 2], a1 = acc[ai][bj][m][q >> 1][(q & 1) * 2 + 1];
                        v[2 * q] = p0 + fast_sigmoid(g0) * a0; v[2 * q + 1] = p1 + fast_sigmoid(g1) * a1; }
                    u32x4 w; w.x = cvt_pk_bf16(v[0], v[1]); w.y = cvt_pk_bf16(v[2], v[3]); w.z = cvt_pk_bf16(v[4], v[5]); w.w = cvt_pk_bf16(v[6], v[7]);
                    *(u32x4*)(O + r * 1024 + col0 + bj * HALF) = w; } }
    }
};

template <class Epi, class Sched, bool ALIGN_EPI = false, bool SP2 = false>
__device__ __forceinline__ void gemm_phase(PG8_LAS unsigned char* lds, const Gemm g, const Sched& S, const Epi& E) {
    const int tid = threadIdx.x, wid = __builtin_amdgcn_readfirstlane(tid >> 6), lane = tid & 63, wr = wid >> 2, wc = wid & 3, fr = lane & 15, fq = lane >> 4;
    const int K = g.K, nt = K / BK;
    unsigned voffA[2], voffB[2];
#pragma unroll
    for (int i = 0; i < 2; ++i) { int R, C; stage_rc(tid * 16 + i * 8192, R, C); const int Rb = Epi::PERM ? ((R & ~31) + perm32(R & 31)) : R;
        voffA[i] = (unsigned)(R * g.lda + C) * 2u; voffB[i] = (unsigned)(Rb * g.ldb + C) * 2u; }
    const size_t kstep = (size_t)(BK * 2);
    const size_t hstepA = (size_t)HALF * g.lda * 2, hstepB = (size_t)HALF * g.ldb * 2;
    const size_t tstepA = 2 * hstepA, tstepB = 2 * hstepB;
    const unsigned ldsw = (unsigned)wid * 1024u;
    const int aoff = lds_byte(wr * 64 + fr, fq * 8), boff = lds_byte(wc * 32 + fr, fq * 8);
#define PG8_SA(b, h) (((b) * 2 + (h)) * HTB)
#define PG8_SB(b, h) ((4 + (b) * 2 + (h)) * HTB)
#define PG8_STAGE(bufoff, gbase, voff) do { _Pragma("unroll") for (int _i = 0; _i < 2; ++_i) \
        __builtin_amdgcn_global_load_lds((const unsigned*)((const char*)(gbase) + (voff)[_i]), (PG8_LAS unsigned*)(lds + (bufoff) + ldsw + _i * 8192), 16, 0, 0); } while (0)
#define PG8_LDA(dst, b, h) do { _Pragma("unroll") for (int m = 0; m < 4; ++m) _Pragma("unroll") for (int k = 0; k < 2; ++k) dst[m][k] = *(const PG8_LAS bf16x8*)(lds + PG8_SA(b, h) + aoff + m * 2048 + k * 1024); } while (0)
#define PG8_LDB(dst, b, h) do { _Pragma("unroll") for (int n = 0; n < 2; ++n) _Pragma("unroll") for (int k = 0; k < 2; ++k) dst[n][k] = *(const PG8_LAS bf16x8*)(lds + PG8_SB(b, h) + boff + n * 2048 + k * 1024); } while (0)
#define PG8_MMA(ai, bj, At, Bt) do { __builtin_amdgcn_s_setprio(1); _Pragma("unroll") for (int m = 0; m < 4; ++m) _Pragma("unroll") for (int n = 0; n < 2; ++n) _Pragma("unroll") for (int k = 0; k < 2; ++k) \
        acc[ai][bj][m][n] = __builtin_amdgcn_mfma_f32_16x16x32_bf16(Bt[n][k], At[m][k], acc[ai][bj][m][n], 0, 0, 0); __builtin_amdgcn_s_setprio(0); } while (0)
#define PG8_WAIT_V(n) asm volatile("s_waitcnt vmcnt(" #n ")" ::: "memory")
#define PG8_WAIT_L(n) asm volatile("s_waitcnt lgkmcnt(" #n ")" ::: "memory")
#define PG8_BAR __builtin_amdgcn_s_barrier()
#define PG8_SCHED __builtin_amdgcn_sched_barrier(0)
    Unit cur, nxt; int ui = 0;
    if (!S.next(0, cur)) return;
    f32x4 acc[2][2][4][2];
#pragma unroll
    for (int a = 0; a < 2; ++a)
#pragma unroll
        for (int b = 0; b < 2; ++b)
#pragma unroll
            for (int m = 0; m < 4; ++m)
#pragma unroll
                for (int n = 0; n < 2; ++n) acc[a][b][m][n] = (f32x4){0.f, 0.f, 0.f, 0.f};
    bf16x8 At[4][2], B0[2][2], B1[2][2];
    const char* cA = (const char*)g.A + (size_t)cur.pm * tstepA; const char* cB = (const char*)g.Bt + (size_t)cur.pn * tstepB;
    S.a_ready(cur);
    if constexpr (SP2) {
        PG8_STAGE(PG8_SB(0, 0), cB, voffB); PG8_STAGE(PG8_SB(0, 1), cB + hstepB, voffB); PG8_STAGE(PG8_SA(0, 0), cA, voffA); PG8_STAGE(PG8_SA(0, 1), cA + hstepA, voffA);
        if (wr == 1) PG8_BAR;
        PG8_WAIT_V(2); PG8_BAR;
        PG8_STAGE(PG8_SB(1, 0), cB + kstep, voffB); PG8_STAGE(PG8_SA(1, 0), cA + kstep, voffA); PG8_STAGE(PG8_SB(1, 1), cB + hstepB + kstep, voffB);
        PG8_WAIT_V(6); PG8_BAR;
    } else {
        PG8_STAGE(PG8_SB(0, 0), cB, voffB); PG8_STAGE(PG8_SA(0, 0), cA, voffA); PG8_STAGE(PG8_SB(0, 1), cB + hstepB, voffB); PG8_STAGE(PG8_SA(0, 1), cA + hstepA, voffA);
        if (wr == 1) PG8_BAR;
        PG8_WAIT_V(4); PG8_BAR;
        PG8_STAGE(PG8_SB(1, 0), cB + kstep, voffB); PG8_STAGE(PG8_SA(1, 0), cA + kstep, voffA); PG8_STAGE(PG8_SB(1, 1), cB + hstepB + kstep, voffB);
        PG8_WAIT_V(6); PG8_BAR;
    }
    for (;;) {
        const bool has_next = S.next(ui + 1, nxt);
        const char* nA = has_next ? (const char*)g.A + (size_t)nxt.pm * tstepA : cA; const char* nB = has_next ? (const char*)g.Bt + (size_t)nxt.pn * tstepB : cB;
        for (int t = 0; t < nt; t += 2) {
            const bool last = (t == nt - 2);
            const char* a1 = cA + (size_t)(t + 1) * kstep;
            const char* a2 = last ? nA : cA + (size_t)(t + 2) * kstep; const char* b2 = last ? nB : cB + (size_t)(t + 2) * kstep;
            const char* a3 = a2 + kstep; const char* b3 = b2 + kstep;
            if (last && has_next) S.a_ready(nxt);
            if constexpr (SP2) {
            PG8_LDB(B0, 0, 0); PG8_LDB(B1, 0, 1); PG8_SCHED; PG8_LDA(At, 0, 0); PG8_STAGE(PG8_SA(1, 1), a1 + hstepA, voffA);
            PG8_WAIT_V(8); PG8_WAIT_L(0); PG8_BAR; PG8_MMA(0, 0, At, B0); PG8_MMA(0, 1, At, B1); PG8_BAR; PG8_SCHED;
            PG8_LDA(At, 0, 1); PG8_STAGE(PG8_SB(0, 0), b2, voffB); PG8_STAGE(PG8_SB(0, 1), b2 + hstepB, voffB); PG8_STAGE(PG8_SA(0, 0), a2, voffA);
            PG8_WAIT_V(8); PG8_WAIT_L(0); PG8_BAR; PG8_MMA(1, 0, At, B0); PG8_MMA(1, 1, At, B1); PG8_BAR; PG8_SCHED;
            PG8_LDB(B0, 1, 0); PG8_LDB(B1, 1, 1); PG8_SCHED; PG8_LDA(At, 1, 0); PG8_STAGE(PG8_SA(0, 1), a2 + hstepA, voffA);
            PG8_WAIT_V(8); PG8_WAIT_L(0); PG8_BAR; PG8_MMA(0, 0, At, B0); PG8_MMA(0, 1, At, B1); PG8_BAR; PG8_SCHED;
            PG8_LDA(At, 1, 1); PG8_STAGE(PG8_SB(1, 0), b3, voffB); PG8_STAGE(PG8_SB(1, 1), b3 + hstepB, voffB); PG8_STAGE(PG8_SA(1, 0), a3, voffA);
            PG8_WAIT_V(8); PG8_WAIT_L(0); PG8_BAR; PG8_MMA(1, 0, At, B0); PG8_MMA(1, 1, At, B1); PG8_BAR; PG8_SCHED;
            } else {
            PG8_LDB(B0, 0, 0); PG8_SCHED; PG8_LDA(At, 0, 0); PG8_STAGE(PG8_SA(1, 1), a1 + hstepA, voffA);
            PG8_WAIT_L(8); PG8_BAR; PG8_WAIT_L(0); PG8_MMA(0, 0, At, B0); PG8_BAR; PG8_SCHED;
            PG8_LDB(B1, 0, 1); PG8_STAGE(PG8_SB(0, 0), b2, voffB);
            PG8_BAR; PG8_WAIT_L(0); PG8_MMA(0, 1, At, B1); PG8_BAR;
            PG8_LDA(At, 0, 1); PG8_STAGE(PG8_SA(0, 0), a2, voffA);
            PG8_BAR; PG8_WAIT_L(0); PG8_MMA(1, 0, At, B0); PG8_BAR; PG8_SCHED;
            PG8_STAGE(PG8_SB(0, 1), b2 + hstepB, voffB);
            PG8_WAIT_V(6); PG8_BAR; PG8_MMA(1, 1, At, B1); PG8_BAR;
            PG8_LDB(B0, 1, 0); PG8_SCHED; PG8_LDA(At, 1, 0); PG8_STAGE(PG8_SA(0, 1), a2 + hstepA, voffA);
            PG8_WAIT_L(8); PG8_BAR; PG8_WAIT_L(0); PG8_MMA(0, 0, At, B0); PG8_BAR; PG8_SCHED;
            PG8_LDB(B1, 1, 1); PG8_STAGE(PG8_SB(1, 0), b3, voffB);
            PG8_BAR; PG8_WAIT_L(0); PG8_MMA(0, 1, At, B1); PG8_BAR;
            PG8_LDA(At, 1, 1); PG8_STAGE(PG8_SA(1, 0), a3, voffA);
            PG8_BAR; PG8_WAIT_L(0); PG8_MMA(1, 0, At, B0); PG8_BAR; PG8_SCHED;
            PG8_STAGE(PG8_SB(1, 1), b3 + hstepB, voffB);
            PG8_WAIT_V(6); PG8_BAR; PG8_MMA(1, 1, At, B1); PG8_BAR;
            }
        }
        if constexpr (ALIGN_EPI) { if (wr == 0) PG8_BAR; }
        if constexpr (!Epi::AFTER_DRAIN) { E(acc, cur, wr, wc, fr, fq); S.done(cur); }
        if (!has_next) break;
#pragma unroll
        for (int a = 0; a < 2; ++a)
#pragma unroll
            for (int b = 0; b < 2; ++b)
#pragma unroll
                for (int m = 0; m < 4; ++m)
#pragma unroll
                    for (int n = 0; n < 2; ++n) acc[a][b][m][n] = (f32x4){0.f, 0.f, 0.f, 0.f};
        cur = nxt; cA = nA; cB = nB; ++ui;
        if constexpr (ALIGN_EPI) { if (wr == 1) PG8_BAR; }
    }
    PG8_WAIT_V(0);
    if constexpr (!ALIGN_EPI) { if (wr == 0) PG8_BAR; }
    PG8_BAR;
    if constexpr (Epi::AFTER_DRAIN) { E.fused(acc, cur, wr, wc, fr, fq, lds, wid, lane); S.done(cur); }
#undef PG8_SA
#undef PG8_SB
#undef PG8_STAGE
#undef PG8_LDA
#undef PG8_LDB
#undef PG8_MMA
#undef PG8_WAIT_V
#undef PG8_WAIT_L
#undef PG8_BAR
#undef PG8_SCHED
}
}

namespace attn {
using bf16x8 = __attribute__((ext_vector_type(8))) short;
using s16x4  = __attribute__((ext_vector_type(4))) short;
using f32x16 = __attribute__((ext_vector_type(16))) float;
using u32x4  = __attribute__((ext_vector_type(4))) unsigned;
constexpr int NW = 8, QBLK = 32, KVBLK = 64, SHM_V = 16384, SHM_K = 16384, LDS_WS = 2 * SHM_V + 2 * SHM_K;
constexpr float THRL = 8.f;
#define ATT_KSWZ(row, colB) ((row) * 256 + ((colB) ^ (((row) & 7) << 4)))
#define ATT_SBAR() __builtin_amdgcn_sched_barrier(0)
__device__ __forceinline__ int crow(int r, int hi) { return (r & 3) + 8 * (r >> 2) + 4 * hi; }
__device__ __forceinline__ unsigned cvtpk(float lo, float hi) { unsigned r; asm volatile("v_cvt_pk_bf16_f32 %0, %1, %2" : "=v"(r) : "v"(lo), "v"(hi)); return r; }
__device__ __forceinline__ void partialSM(f32x16& p0, f32x16& p1, float& m_reg, float& mn, float& alpha) {
  float pmax = p0[0];
#pragma unroll
  for (int r = 1; r < 16; ++r) pmax = fmaxf(pmax, p0[r]);
#pragma unroll
  for (int r = 0; r < 16; ++r) pmax = fmaxf(pmax, p1[r]);
  { auto rr = __builtin_amdgcn_permlane32_swap(__float_as_uint(pmax), __float_as_uint(pmax), false, false);
    pmax = fmaxf(__uint_as_float(rr[0]), __uint_as_float(rr[1])); }
  if (__builtin_expect(__all(pmax - m_reg <= THRL), 1)) { mn = m_reg; alpha = 1.f; }
  else { mn = fmaxf(m_reg, pmax); alpha = __builtin_amdgcn_exp2f(m_reg - mn); m_reg = mn; }
#pragma unroll
  for (int r = 0; r < 16; ++r) { p0[r] = p0[r] - mn; p1[r] = p1[r] - mn; }
#pragma unroll
  for (int r = 0; r < 16; ++r) p0[r] = __builtin_amdgcn_exp2f(p0[r]);
}
__device__ __forceinline__ void finishSM(f32x16& p0, f32x16& p1, float alpha, float& l_reg, bf16x8& pa0, bf16x8& pa1, bf16x8& pa2, bf16x8& pa3) {
#pragma unroll
  for (int r = 0; r < 16; ++r) p1[r] = __builtin_amdgcn_exp2f(p1[r]);
  float ps = 0;
#pragma unroll
  for (int r = 0; r < 16; ++r) ps += p0[r];
#pragma unroll
  for (int r = 0; r < 16; ++r) ps += p1[r];
  { auto rr = __builtin_amdgcn_permlane32_swap(__float_as_uint(ps), __float_as_uint(ps), false, false);
    ps = __uint_as_float(rr[0]) + __uint_as_float(rr[1]); }
  l_reg = l_reg * alpha + ps;
#define ATT_PK4(P, BASE, OUT) do { unsigned a0 = cvtpk(P[BASE + 0], P[BASE + 1]), a1 = cvtpk(P[BASE + 2], P[BASE + 3]);   \
    unsigned b0 = cvtpk(P[BASE + 4], P[BASE + 5]), b1 = cvtpk(P[BASE + 6], P[BASE + 7]);                              \
    auto r0 = __builtin_amdgcn_permlane32_swap(a0, b0, false, false); auto r1 = __builtin_amdgcn_permlane32_swap(a1, b1, false, false); \
    u32x4 w = {r0[0], r1[0], r0[1], r1[1]}; OUT = __builtin_bit_cast(bf16x8, w); } while (0)
  ATT_PK4(p0, 0, pa0); ATT_PK4(p0, 8, pa1); ATT_PK4(p1, 0, pa2); ATT_PK4(p1, 8, pa3);
#undef ATT_PK4
}
template <int DQK> __device__ __forceinline__ void qkt(f32x16& p0, f32x16& p1, const LAS char* Ks, const bf16x8* qr, int r32, int hi) {
  p0 = f32x16{}; p1 = f32x16{};
#pragma unroll
  for (int d0 = 0; d0 < DQK / 16; ++d0) { const int cb = (d0 * 16 + hi * 8) * 2;
    const bf16x8 b0 = *reinterpret_cast<const LAS bf16x8*>(Ks + ATT_KSWZ(r32, cb));
    const bf16x8 b1 = *reinterpret_cast<const LAS bf16x8*>(Ks + ATT_KSWZ(32 + r32, cb));
    p0 = __builtin_amdgcn_mfma_f32_32x32x16_bf16(b0, qr[d0], p0, 0, 0, 0);
    p1 = __builtin_amdgcn_mfma_f32_32x32x16_bf16(b1, qr[d0], p1, 0, 0, 0); }
}
__device__ __forceinline__ int v_st(int k, int c) { const int kk = (k & ~0xC) | ((k & 4) << 1) | ((k & 8) >> 1); return ((kk >> 3) * 4 + (c >> 5)) * 512 + ((kk & 7) * 32 + (c & 31)) * 2; }
__device__ __forceinline__ int v_rd_base(int lane) { return ((lane & 3) << 3) | (((lane >> 2) & 3) << 6) | (((lane >> 4) & 1) << 5) | (((lane >> 5) & 1) << 8); }
constexpr int v_rd_off(int d0, int ks, int half) { return d0 * 512 + ks * 4096 + half * 2048; }
template <int OFF> __device__ __forceinline__ s16x4 tr_read(int vb) { s16x4 r; asm volatile("ds_read_b64_tr_b16 %0, %1 offset:%2" : "=&v"(r) : "v"(vb), "i"(OFF) : "memory"); return r; }
template <int D0> __device__ __forceinline__ void pv_one(f32x16& od, int vb, bf16x8 pa0, bf16x8 pa1, bf16x8 pa2, bf16x8 pa3) {
  const s16x4 l0 = tr_read<v_rd_off(D0, 0, 0)>(vb), h0 = tr_read<v_rd_off(D0, 0, 1)>(vb), l1 = tr_read<v_rd_off(D0, 1, 0)>(vb), h1 = tr_read<v_rd_off(D0, 1, 1)>(vb);
  const s16x4 l2 = tr_read<v_rd_off(D0, 2, 0)>(vb), h2 = tr_read<v_rd_off(D0, 2, 1)>(vb), l3 = tr_read<v_rd_off(D0, 3, 0)>(vb), h3 = tr_read<v_rd_off(D0, 3, 1)>(vb);
  asm volatile("s_waitcnt lgkmcnt(0)" ::: "memory"); ATT_SBAR();
#define ATT_PK(L, H) (bf16x8){L[0], L[1], L[2], L[3], H[0], H[1], H[2], H[3]}
  od = __builtin_amdgcn_mfma_f32_32x32x16_bf16(pa0, ATT_PK(l0, h0), od, 0, 0, 0);
  od = __builtin_amdgcn_mfma_f32_32x32x16_bf16(pa1, ATT_PK(l1, h1), od, 0, 0, 0);
  od = __builtin_amdgcn_mfma_f32_32x32x16_bf16(pa2, ATT_PK(l2, h2), od, 0, 0, 0);
  od = __builtin_amdgcn_mfma_f32_32x32x16_bf16(pa3, ATT_PK(l3, h3), od, 0, 0, 0);
#undef ATT_PK
}
template <int DV> __device__ __forceinline__ void pv_all(f32x16 (&o)[DV / 32], int vb, bf16x8 pa0, bf16x8 pa1, bf16x8 pa2, bf16x8 pa3) {
  pv_one<0>(o[0], vb, pa0, pa1, pa2, pa3); pv_one<1>(o[1], vb, pa0, pa1, pa2, pa3);
  if constexpr (DV == 128) { pv_one<2>(o[2], vb, pa0, pa1, pa2, pa3); pv_one<3>(o[3], vb, pa0, pa1, pa2, pa3); }
}
template <int DQK, int DV>
__device__ __forceinline__ void sweep(const bf16* __restrict__ Qb, int ldq, const bf16* __restrict__ Kh, int ldk, const bf16* __restrict__ Vh, int ldv,
                                      f32x16 (&o)[DV / 32], float& l_out, LAS char* lds) {
  int tid_ = threadIdx.x; asm volatile("" : "+v"(tid_));
  const int tid = tid_, wid = tid >> 6, lane = tid & 63, r32 = lane & 31, hi = lane >> 5;
  LAS char* V_lds = lds; LAS char* K_lds = lds + 2 * SHM_V;
  LAS float* al_l = (LAS float*)(lds + LDS_WS) + wid * 64 + 32;
  float m_reg = -1e30f, l_reg = 0;
#pragma unroll
  for (int d = 0; d < DV / 32; ++d) o[d] = f32x16{};
  bf16x8 qr[DQK / 16];
  const bf16* Qw = Qb + (long)(wid * QBLK + r32) * ldq + hi * 8;
#pragma unroll
  for (int d0 = 0; d0 < DQK / 16; ++d0) qr[d0] = *reinterpret_cast<const bf16x8*>(Qw + d0 * 16);
  constexpr bool K2 = (DQK > 64), V2 = (DV > 64);
  static_assert(K2 != V2, "exactly one of K / V is a two-load operand (vmcnt(3) below counts three loads per tile)");
  const int sr = tid >> 4, sc = (tid & 15) * 8, sr1 = tid >> 3, sc1 = (tid & 7) * 8;
  const int vst0 = V2 ? v_st(sr, sc) : v_st(sr1, sc1), vst1 = v_st(32 + sr, sc);
  const int kst0 = K2 ? ATT_KSWZ(sr, sc * 2) : ATT_KSWZ(sr1, sc1 * 2), kst1 = ATT_KSWZ(32 + sr, sc * 2);
  const int vb0 = (int)(unsigned)(uintptr_t)V_lds + v_rd_base(lane);
  bf16x8 sE_v0, sE_v1, sE_k0, sE_k1, sO_v0, sO_v1, sO_k0, sO_k1;
#define ATT_SLOAD(S, k0) do { \
    if constexpr (V2) { S##_v0 = *reinterpret_cast<const bf16x8*>(&Vh[(long)((k0) + sr) * ldv + sc]); S##_v1 = *reinterpret_cast<const bf16x8*>(&Vh[(long)((k0) + 32 + sr) * ldv + sc]); } \
    else S##_v0 = *reinterpret_cast<const bf16x8*>(&Vh[(long)((k0) + sr1) * ldv + sc1]); \
    if constexpr (K2) { S##_k0 = *reinterpret_cast<const bf16x8*>(&Kh[(long)((k0) + sr) * ldk + sc]); S##_k1 = *reinterpret_cast<const bf16x8*>(&Kh[(long)((k0) + 32 + sr) * ldk + sc]); } \
    else S##_k0 = *reinterpret_cast<const bf16x8*>(&Kh[(long)((k0) + sr1) * ldk + sc1]); } while (0)
#define ATT_SWRITE(b, S) do { *(LAS bf16x8*)(V_lds + (b) * SHM_V + vst0) = S##_v0; if constexpr (V2) *(LAS bf16x8*)(V_lds + (b) * SHM_V + vst1) = S##_v1; \
    *(LAS bf16x8*)(K_lds + (b) * SHM_K + kst0) = S##_k0; if constexpr (K2) *(LAS bf16x8*)(K_lds + (b) * SHM_K + kst1) = S##_k1; } while (0)
#define ATT_SWAIT() asm volatile("s_waitcnt vmcnt(3)" ::: "memory")
#define ATT_RESC(a) do { if (__any((a) < 1.f)) { if (hi == 0) al_l[r32] = (a); asm volatile("s_waitcnt lgkmcnt(0)" ::: "memory"); \
    _Pragma("unroll") for (int d = 0; d < DV / 32; ++d) _Pragma("unroll") for (int r = 0; r < 16; ++r) o[d][r] *= al_l[crow(r, hi)]; } } while (0)
  f32x16 pA0, pA1, pB0, pB1; float mnA, mnB, alA, alB; bf16x8 pa0, pa1, pa2, pa3; constexpr int NT = SEQ / KVBLK;
  ATT_SLOAD(sE, 0); asm volatile("s_waitcnt vmcnt(0)" ::: "memory"); ATT_SWRITE(0, sE); __syncthreads();
  qkt<DQK>(pA0, pA1, K_lds, qr, r32, hi); partialSM(pA0, pA1, m_reg, mnA, alA);
  ATT_SLOAD(sO, KVBLK); ATT_SLOAD(sE, 2 * KVBLK);
  ATT_SWAIT(); ATT_SWRITE(1, sO); __syncthreads();
  for (int j = 1; j + 1 < NT; j += 2) {
    ATT_SBAR(); qkt<DQK>(pB0, pB1, K_lds + SHM_K, qr, r32, hi);
    finishSM(pA0, pA1, alA, l_reg, pa0, pa1, pa2, pa3); ATT_SBAR();
    ATT_SLOAD(sO, (j + 2) * KVBLK); ATT_SBAR();
    pv_all<DV>(o, vb0, pa0, pa1, pa2, pa3); partialSM(pB0, pB1, m_reg, mnB, alB);
    __syncthreads(); ATT_SWAIT(); ATT_SWRITE(0, sE);
    ATT_RESC(alB); __syncthreads();
    ATT_SBAR(); qkt<DQK>(pA0, pA1, K_lds, qr, r32, hi);
    finishSM(pB0, pB1, alB, l_reg, pa0, pa1, pa2, pa3); ATT_SBAR();
    if (j + 3 < NT) ATT_SLOAD(sE, (j + 3) * KVBLK); ATT_SBAR();
    pv_all<DV>(o, vb0 + SHM_V, pa0, pa1, pa2, pa3); partialSM(pA0, pA1, m_reg, mnA, alA);
    __syncthreads(); ATT_SWAIT(); ATT_SWRITE(1, sO);
    ATT_RESC(alA); __syncthreads();
  }
  ATT_SBAR(); qkt<DQK>(pB0, pB1, K_lds + SHM_K, qr, r32, hi);
  finishSM(pA0, pA1, alA, l_reg, pa0, pa1, pa2, pa3); ATT_SBAR();
  pv_all<DV>(o, vb0, pa0, pa1, pa2, pa3); partialSM(pB0, pB1, m_reg, mnB, alB);
  __syncthreads(); ATT_RESC(alB);
  finishSM(pB0, pB1, alB, l_reg, pa0, pa1, pa2, pa3); ATT_SBAR();
  pv_all<DV>(o, vb0 + SHM_V, pa0, pa1, pa2, pa3);
  l_out = l_reg;
  asm volatile("s_waitcnt vmcnt(0) lgkmcnt(0)" ::: "memory"); __syncthreads();
#undef ATT_SLOAD
#undef ATT_SWRITE
#undef ATT_SWAIT
#undef ATT_RESC
}
__device__ __forceinline__ void row_recip(float l_reg, float (&rli)[16], LAS char* lds, int wid, int r32, int hi) {
  LAS float* li_l = (LAS float*)(lds + LDS_WS) + wid * 64;
  if (hi == 0) li_l[r32] = l_reg; asm volatile("s_waitcnt lgkmcnt(0)" ::: "memory");
#pragma unroll
  for (int r = 0; r < 16; ++r) rli[r] = __builtin_amdgcn_rcpf(li_l[crow(r, hi)]);
  asm volatile("s_waitcnt lgkmcnt(0)" ::: "memory");
}
}
struct Args { const void* in[32]; float* out; unsigned char* ws; int ph_lo, ph_hi; };

struct Frame {
    LAS unsigned char* lds;
    int tid, lane, wave, G, bid;
    const void* const* in;
    unsigned char* ws; float* H;
};
#define FIN(i) ((const float*)F.in[i])
#define F_x FIN(0)
#define F_c FIN(1)
#define F_pos ((const int*)F.in[2])
#define F_w_ada FIN(3)
#define F_b_ada FIN(4)
#define F_ffn1_norm FIN(5)
#define F_ffn1_wg FIN(6)
#define F_ffn1_wu FIN(7)
#define F_ffn1_wd FIN(8)
#define F_mix_norm FIN(9)
#define F_w_in FIN(10)
#define F_q_norm FIN(11)
#define F_w_uq FIN(12)
#define F_kv_norm FIN(13)
#define F_w_ukv FIN(14)
#define F_q_gain FIN(15)
#define F_k_gain FIN(16)
#define F_mla_wo FIN(17)
#define F_dq_gain FIN(18)
#define F_dk_gain FIN(19)
#define F_lq1 FIN(20)
#define F_lk1 FIN(21)
#define F_lq2 FIN(22)
#define F_lk2 FIN(23)
#define F_subln FIN(24)
#define F_diff_wo FIN(25)
#define F_w_out FIN(26)
#define F_ffn2_norm FIN(27)
#define F_ffn2_wg FIN(28)
#define F_ffn2_wu FIN(29)
#define F_ffn2_wd FIN(30)
#define F_final_norm FIN(31)
#define F_MOD ((float*)(F.ws + WS_MOD))
#define F_XN ((bf16*)(F.ws + WS_XN))
#define F_ACT ((bf16*)(F.ws + WS_ACT))
#define F_ZA ((bf16*)(F.ws + WS_ZA))
#define F_ZB ((bf16*)(F.ws + WS_ZB))
#define F_ZG ((bf16*)(F.ws + WS_ZG))
#define F_QM ((bf16*)(F.ws + WS_QM))
#define F_KM ((bf16*)(F.ws + WS_KM))
#define F_VM ((bf16*)(F.ws + WS_VM))
#define F_OMD ((bf16*)(F.ws + WS_OMD))
#define F_MRG ((bf16*)(F.ws + WS_MRG))


typedef unsigned v4u __attribute__((ext_vector_type(4)));
__device__ __forceinline__ unsigned pk2(float lo, float hi) { return (unsigned)f2bf(lo) | ((unsigned)f2bf(hi) << 16); }
__device__ __forceinline__ void tr_item(const float* W, int ldw, int k0, int n0, bf16* WT, int ldk, int drow0, int dk0, LAS float* scr, int lane, const float* kgain = nullptr) {
#pragma unroll 8
    for (int i = 0; i < 32; ++i) { const int kk = 2 * i + (lane >> 5); float w = W[(size_t)(k0 + kk) * ldw + n0 + (lane & 31)]; if (kgain) w *= kgain[k0 + kk]; scr[kk * 33 + (lane & 31)] = w; }
    asm volatile("s_waitcnt lgkmcnt(0)" ::: "memory");
    const int c = lane & 7;
#pragma unroll
    for (int j = 0; j < 4; ++j) { const int n = (lane >> 3) + 8 * j; const LAS float* s = scr + (8 * c) * 33 + n;
        v4u o; o.x = pk2(s[0 * 33], s[1 * 33]); o.y = pk2(s[2 * 33], s[3 * 33]); o.z = pk2(s[4 * 33], s[5 * 33]); o.w = pk2(s[6 * 33], s[7 * 33]);
        *(v4u*)(WT + (size_t)(drow0 + n) * ldk + dk0 + k0 + 8 * c) = o; }
    asm volatile("s_waitcnt lgkmcnt(0)" ::: "memory");
}
constexpr int IT_FFN_GU = (D / 64) * (DFF / 32), IT_FFN_D = (DFF / 64) * (D / 32);
__device__ __forceinline__ void tr_ffn(Frame& F, const float* wg, const float* wu, const float* wd, int gw, int NGW) {
    LAS float* scr = (LAS float*)(F.lds + F.wave * 16384);
    bf16* WUP = (bf16*)(F.ws + WS_WUP); bf16* WDN = (bf16*)(F.ws + WS_WDN);
    for (int it = gw; it < 2 * IT_FFN_GU + IT_FFN_D; it += NGW) {
        if (it < 2 * IT_FFN_GU) { const int up = it >= IT_FFN_GU, r = up ? it - IT_FFN_GU : it, nblk = DFF / 32, kb = r / nblk, nb = r % nblk, n0 = 32 * nb;
            tr_item(up ? wu : wg, DFF, 64 * kb, n0, WUP, D, 256 * (n0 >> 7) + (n0 & 127) + 128 * up, 0, scr, F.lane); }
        else { const int r = it - 2 * IT_FFN_GU, nblk = D / 32, kb = r / nblk, nb = r % nblk;
            tr_item(wd, D, 64 * kb, 32 * nb, WDN, DFF, 32 * nb, 0, scr, F.lane); }
    }
}
constexpr int IT_WIN = (D / 64) * (IN_COLS / 32), IT_WO = (512 / 64) * (D / 32), IT_WOUT = (D / 64) * (D / 32);
constexpr int IT_WUQ = (QLORA / 64) * (768 / 32), IT_WUKV = (KVLORA / 64) * (1024 / 32);
__device__ __forceinline__ int win_row(int n0) {
    if (n0 < 672) return n0;
    if (n0 < 1696) { const int zb = n0 - 672, t = zb >> 8, cl = zb & 255, chunk = cl >> 6, d = cl & 63; return 768 + 256 * t + 128 * (d >> 5) + 32 * chunk + (d & 31); }
    return n0 + 96;
}
__device__ __forceinline__ void tr_misc(Frame& F, int gw, int NGW) {
    LAS float* scr = (LAS float*)(F.lds + F.wave * 16384);
    bf16* WIN = (bf16*)(F.ws + WS_WIN); bf16* WO = (bf16*)(F.ws + WS_WO); bf16* WOUT = (bf16*)(F.ws + WS_WOUT);
    for (int it = gw; it < IT_WIN + 2 * IT_WO + IT_WOUT + IT_WUQ + IT_WUKV; it += NGW) {
        int r = it;
        if (r < IT_WIN) { const int nblk = IN_COLS / 32, kb = r / nblk, nb = r % nblk, n0 = 32 * nb;
            tr_item(F_w_in, IN_COLS, 64 * kb, n0, WIN, D, win_row(n0), 0, scr, F.lane); continue; } r -= IT_WIN;
        if (r < 2 * IT_WO) { const int second = r >= IT_WO, q = second ? r - IT_WO : r, nblk = D / 32, kb = q / nblk, nb = q % nblk;
            tr_item(second ? F_diff_wo : F_mla_wo, D, 64 * kb, 32 * nb, WO, D, 32 * nb, 512 * second, scr, F.lane); continue; } r -= 2 * IT_WO;
        if (r < IT_WOUT) { const int nblk = D / 32, kb = r / nblk, nb = r % nblk; tr_item(F_w_out, D, 64 * kb, 32 * nb, WOUT, D, 32 * nb, 0, scr, F.lane); continue; } r -= IT_WOUT;
        if (r < IT_WUQ) { const int nblk = 768 / 32, kb = r / nblk, nb = r % nblk;
            tr_item(F_w_uq, 768, 64 * kb, 32 * nb, (bf16*)(F.ws + WS_WUQ), QLORA, 32 * nb, 0, scr, F.lane, F_q_norm); continue; } r -= IT_WUQ;
        { const int nblk = 1024 / 32, kb = r / nblk, nb = r % nblk;
            tr_item(F_w_ukv, 1024, 64 * kb, 32 * nb, (bf16*)(F.ws + WS_WUKV), KVLORA, 32 * nb, 0, scr, F.lane, F_kv_norm); }
    }
    for (int i = gw * 64 + F.lane; i < 96 * D / 8; i += NGW * 64) *(v4u*)(WIN + (size_t)672 * D + (size_t)i * 8) = (v4u){0u, 0u, 0u, 0u};
    float* TD = (float*)(F.ws + WS_TABD); float* TM = (float*)(F.ws + WS_TABM);
    for (int i = gw * 64 + F.lane; i < 4096 * 24; i += NGW * 64) {
        if (i < 4096 * 8) { const int p = i >> 3, k = i & 7; float sn, cs; sincos_red((float)p * exp2f(-18.931568569324174f * (float)k * (1.f / 8.f)), sn, cs); TD[2 * i] = cs; TD[2 * i + 1] = sn; }
        else { const int q = i - 4096 * 8, p = q >> 4, k = q & 15; float sn, cs; sincos_red((float)p * exp2f(-13.287712379549449f * (float)k * (1.f / 16.f)), sn, cs); TM[2 * q] = cs; TM[2 * q + 1] = sn; }
    }
}

typedef unsigned u32x4_t __attribute__((ext_vector_type(4)));
__device__ __forceinline__ void unpack8(const u32x4_t v, float (&f)[8]) {
#pragma unroll
    for (int q = 0; q < 4; ++q) { f[2 * q] = __uint_as_float(v[q] << 16); f[2 * q + 1] = __uint_as_float(v[q] & 0xffff0000u); }
}
__device__ __forceinline__ u32x4_t pack8(const float (&f)[8]) { u32x4_t w; w.x = pk2(f[0], f[1]); w.y = pk2(f[2], f[3]); w.z = pk2(f[4], f[5]); w.w = pk2(f[6], f[7]); return w; }
__device__ __forceinline__ void ph_mla_rowop(Frame& F) {
    const int gw = F.bid * NWAVES + F.wave, NGW = F.G * NWAVES, lane = F.lane;
    const float* TM = (const float*)(F.ws + WS_TABM);
    const bf16* KVR = (const bf16*)(F.ws + WS_KVR);
    for (int m = gw; m < M; m += NGW) {
        const bf16* za = F_ZA + (size_t)m * ZA_LD;
        float sq = 0.f, skv = 0.f, skr = 0.f; float kr[32];
        if (lane < 48) { float f[8]; unpack8(*(const u32x4_t*)(za + 8 * lane), f);
#pragma unroll
            for (int i = 0; i < 8; ++i) sq += f[i] * f[i]; }
        if (lane < 32) { float f[8]; unpack8(*(const u32x4_t*)(za + QLORA + 8 * lane), f);
#pragma unroll
            for (int i = 0; i < 8; ++i) skv += f[i] * f[i]; }
#pragma unroll
        for (int c = 0; c < 4; ++c) { float f[8]; unpack8(*(const u32x4_t*)(za + QLORA + KVLORA + 8 * c), f);
#pragma unroll
            for (int i = 0; i < 8; ++i) { kr[8 * c + i] = f[i]; skr += f[i] * f[i]; } }
        const float s_q = 1.f / sqrtf(wave_sum(sq) * (1.f / QLORA) + EPS), s_kv = 1.f / sqrtf(wave_sum(skv) * (1.f / KVLORA) + EPS);
        const int p = F_pos[m]; float cs[16], sn[16];
#pragma unroll
        for (int i = 0; i < 8; ++i) { const f32x4 t = *(const f32x4*)(TM + (size_t)p * 32 + 4 * i); cs[2 * i] = t.x; sn[2 * i] = t.y; cs[2 * i + 1] = t.z; sn[2 * i + 1] = t.w; }
        {
            const int lq = lane < 48 ? lane : 47, h = lq / 6, part = lq % 6;
            bf16* qp = F_QM + (size_t)m * 768 + h * MLA_QK + 16 * part;
            float x[16];
            { float f[8]; unpack8(*(const u32x4_t*)qp, f);
#pragma unroll
              for (int i = 0; i < 8; ++i) x[i] = f[i] * s_q;
              unpack8(*(const u32x4_t*)(qp + 8), f);
#pragma unroll
              for (int i = 0; i < 8; ++i) x[8 + i] = f[i] * s_q; }
            float ss = 0.f;
#pragma unroll
            for (int i = 0; i < 16; ++i) ss += x[i] * x[i];
            float tot = 0.f;
#pragma unroll
            for (int k = 0; k < 6; ++k) tot += __shfl(ss, 6 * h + k);
            const float sc = 1.f / sqrtf(tot * (1.f / MLA_QK) + EPS) * C2_MLA;
#pragma unroll
            for (int i = 0; i < 16; ++i) x[i] *= sc * F_q_gain[16 * part + i];
            float y[16];
#pragma unroll
            for (int i = 0; i < 16; ++i) { const float oth = __shfl_xor(x[i], 1);
                y[i] = (part == 4) ? x[i] * cs[i] - oth * sn[i] : (part == 5) ? x[i] * cs[i] + oth * sn[i] : x[i]; }
            if (lane < 48) { float f[8];
#pragma unroll
                for (int i = 0; i < 8; ++i) f[i] = y[i];
                *(u32x4_t*)qp = pack8(f);
#pragma unroll
                for (int i = 0; i < 8; ++i) f[i] = y[8 + i];
                *(u32x4_t*)(qp + 8) = pack8(f); }
        }
        {
            const int h = lane >> 3, part = lane & 7;
            const bf16* rp = KVR + (size_t)m * 1024 + h * 128 + 16 * part;
            float x[16];
            { float f[8]; unpack8(*(const u32x4_t*)rp, f);
#pragma unroll
              for (int i = 0; i < 8; ++i) x[i] = f[i] * s_kv;
              unpack8(*(const u32x4_t*)(rp + 8), f);
#pragma unroll
              for (int i = 0; i < 8; ++i) x[8 + i] = f[i] * s_kv; }
            float ss = 0.f;
#pragma unroll
            for (int i = 0; i < 16; ++i) ss += x[i] * x[i];
            ss += __shfl_xor(ss, 1); ss += __shfl_xor(ss, 2);
            const float sskn = __shfl(ss, lane & ~7);
            const float sc = 1.f / sqrtf((sskn + skr) * (1.f / MLA_QK) + EPS);
            if (part < 4) { float f[8]; bf16* kp = F_KM + (size_t)m * 768 + h * MLA_QK + 16 * part;
#pragma unroll
                for (int i = 0; i < 8; ++i) f[i] = x[i] * sc * F_k_gain[16 * part + i];
                *(u32x4_t*)kp = pack8(f);
#pragma unroll
                for (int i = 0; i < 8; ++i) f[i] = x[8 + i] * sc * F_k_gain[16 * part + 8 + i];
                *(u32x4_t*)(kp + 8) = pack8(f); }
            else { float f[8]; bf16* vp = F_VM + (size_t)m * 512 + h * MLA_V + 16 * (part - 4);
#pragma unroll
                for (int i = 0; i < 8; ++i) f[i] = x[i];
                *(u32x4_t*)vp = pack8(f);
#pragma unroll
                for (int i = 0; i < 8; ++i) f[i] = x[8 + i];
                *(u32x4_t*)(vp + 8) = pack8(f);
                if (part < 6) { float y[16];
#pragma unroll
                    for (int i = 0; i < 16; ++i) { const float x1 = kr[i] * sc * F_k_gain[64 + i], x2 = kr[16 + i] * sc * F_k_gain[80 + i];
                        y[i] = (part == 4) ? x1 * cs[i] - x2 * sn[i] : x2 * cs[i] + x1 * sn[i]; }
                    bf16* kp = F_KM + (size_t)m * 768 + h * MLA_QK + 64 + 16 * (part - 4);
#pragma unroll
                    for (int i = 0; i < 8; ++i) f[i] = y[i];
                    *(u32x4_t*)kp = pack8(f);
#pragma unroll
                    for (int i = 0; i < 8; ++i) f[i] = y[8 + i];
                    *(u32x4_t*)(kp + 8) = pack8(f); } }
        }
    }
}

__device__ __forceinline__ void ph_adaln(Frame& F) {
    LAS float* condL = (LAS float*)F.lds;
    LAS float* red = condL + 8 * 1024;
    for (int i = F.tid; i < 8 * 1024; i += NTHR) condL[i] = silu_f(F_c[i]);
    __syncthreads();
    constexpr int CPB = ADA / 256;
    for (int it = F.bid; it < 256; it += F.G) {
        const int n0 = it * CPB, col = F.tid % CPB, kg = F.tid / CPB;
        float acc[8];
#pragma unroll
        for (int b = 0; b < 8; ++b) acc[b] = 0.f;
        if (kg < 14) for (int k = kg; k < D; k += 14) { const float w = F_w_ada[(size_t)k * ADA + n0 + col];
#pragma unroll
            for (int b = 0; b < 8; ++b) acc[b] += condL[b * 1024 + k] * w; }
        if (kg < 14) {
#pragma unroll
            for (int b = 0; b < 8; ++b) red[(kg * CPB + col) * 8 + b] = acc[b]; }
        __syncthreads();
        if (F.tid < CPB * 8) { const int cc = F.tid / 8, b = F.tid % 8; float s = F_b_ada[n0 + cc];
            for (int g = 0; g < 14; ++g) s += red[(g * CPB + cc) * 8 + b];
            F_MOD[b * ADA + n0 + cc] = s; }
        __syncthreads();
    }
}
__device__ __forceinline__ void ph_norm_mod(Frame& F, const float* src, const float* gain, int sh_off, int sc_off, bf16* dst) {
    const int gw = F.bid * NWAVES + F.wave, NGW = F.G * NWAVES;
    for (int m = gw; m < M; m += NGW) {
        const int b = m / SEQ;
        const f32x4* xr = (const f32x4*)(src + (size_t)m * D) + F.lane;
        f32x4 v[4]; float s = 0.f;
#pragma unroll
        for (int j = 0; j < 4; ++j) { v[j] = xr[64 * j]; s += (v[j].x * v[j].x + v[j].y * v[j].y) + (v[j].z * v[j].z + v[j].w * v[j].w); }
        const float rstd = 1.f / sqrtf(wave_sum(s) * (1.f / D) + EPS);
#pragma unroll
        for (int j = 0; j < 4; ++j) {
            const int c0 = 4 * F.lane + 256 * j;
            const f32x4 g = *(const f32x4*)(gain + c0), sc = *(const f32x4*)(F_MOD + b * ADA + sc_off + c0), sh = *(const f32x4*)(F_MOD + b * ADA + sh_off + c0);
            const f32x4 o = v[j] * rstd * g * (1.f + sc) + sh;
            ushort4 w; w.x = f2bf(o.x); w.y = f2bf(o.y); w.z = f2bf(o.z); w.w = f2bf(o.w);
            *(ushort4*)(dst + (size_t)m * D + c0) = w;
        }
    }
}
__device__ __forceinline__ void ph_final_norm(Frame& F) {
    const int gw = F.bid * NWAVES + F.wave, NGW = F.G * NWAVES;
    for (int m = gw; m < M; m += NGW) {
        f32x4* xr = (f32x4*)(F.H + (size_t)m * D) + F.lane;
        f32x4 v[4]; float s = 0.f;
#pragma unroll
        for (int j = 0; j < 4; ++j) { v[j] = xr[64 * j]; s += (v[j].x * v[j].x + v[j].y * v[j].y) + (v[j].z * v[j].z + v[j].w * v[j].w); }
        const float rstd = 1.f / sqrtf(wave_sum(s) * (1.f / D) + EPS);
#pragma unroll
        for (int j = 0; j < 4; ++j) { const f32x4 g = *(const f32x4*)(F_final_norm + 4 * F.lane + 256 * j); xr[64 * j] = v[j] * rstd * g; }
    }
}

template <int R, int NMAT, class Epi>
__device__ __forceinline__ void naive_gemm(Frame& F, const bf16* A0, const bf16* A1, int lda, int K, const float* W0, const float* W1, int ldw, int N, const Epi& epi) {
    LAS float* L0 = (LAS float*)F.lds;
    const bool sameA = (A1 == A0) || (NMAT == 1);
    LAS float* L1 = sameA ? L0 : L0 + (size_t)K * R;
    for (int rb = F.bid; rb < M / R; rb += F.G) {
        const int r0 = rb * R;
        for (int i = F.tid; i < R * K; i += NTHR) { const int r = i / K, k = i % K; L0[k * R + r] = bf2f(A0[(size_t)(r0 + r) * lda + k]); }
        if (!sameA) for (int i = F.tid; i < R * K; i += NTHR) { const int r = i / K, k = i % K; L1[k * R + r] = bf2f(A1[(size_t)(r0 + r) * lda + k]); }
        __syncthreads();
        for (int n = F.tid; n < N; n += NTHR) {
            float acc0[R], acc1[R];
#pragma unroll
            for (int r = 0; r < R; ++r) { acc0[r] = 0.f; acc1[r] = 0.f; }
#pragma unroll 4
            for (int k = 0; k < K; ++k) {
                const float w0 = W0[(size_t)k * ldw + n];
                float w1 = 0.f; if (NMAT == 2) w1 = W1[(size_t)k * ldw + n];
#pragma unroll
                for (int r4 = 0; r4 < R / 4; ++r4) {
                    const f32x4 a = *(const LAS f32x4*)(L0 + k * R + 4 * r4);
                    acc0[4 * r4 + 0] += a.x * w0; acc0[4 * r4 + 1] += a.y * w0; acc0[4 * r4 + 2] += a.z * w0; acc0[4 * r4 + 3] += a.w * w0;
                    if (NMAT == 2) { const f32x4 a1 = *(const LAS f32x4*)(L1 + k * R + 4 * r4);
                        acc1[4 * r4 + 0] += a1.x * w1; acc1[4 * r4 + 1] += a1.y * w1; acc1[4 * r4 + 2] += a1.z * w1; acc1[4 * r4 + 3] += a1.w * w1; }
                }
            }
#pragma unroll
            for (int r = 0; r < R; ++r) epi(r0 + r, n, acc0[r], acc1[r]);
        }
        __syncthreads();
    }
}

__device__ __forceinline__ void ph_mla_prep(Frame& F) {
    constexpr int R = 16;
    LAS float* A = (LAS float*)F.lds;
    LAS float* SC = A + 384 * R;
    LAS float* OUT = SC + 64;
    for (int rb = F.bid; rb < M / R; rb += F.G) {
        const int r0 = rb * R;
        for (int i = F.tid; i < R * QLORA; i += NTHR) { const int r = i / QLORA, k = i % QLORA; A[k * R + r] = bf2f(F_ZA[(size_t)(r0 + r) * ZA_LD + k]); }
        __syncthreads();
        if (F.tid < R) { float ss = 0.f; for (int k = 0; k < QLORA; ++k) { const float v = A[k * R + F.tid]; ss += v * v; } SC[F.tid] = 1.f / sqrtf(ss * (1.f / QLORA) + EPS); }
        __syncthreads();
        for (int i = F.tid; i < R * QLORA; i += NTHR) { const int r = i % R, k = i / R; A[k * R + r] *= SC[r] * F_q_norm[k]; }
        __syncthreads();
        for (int n = F.tid; n < MLA_H * MLA_QK; n += NTHR) {
            float acc[R];
#pragma unroll
            for (int r = 0; r < R; ++r) acc[r] = 0.f;
#pragma unroll 4
            for (int k = 0; k < QLORA; ++k) { const float w = F_w_uq[(size_t)k * (MLA_H * MLA_QK) + n];
#pragma unroll
                for (int r4 = 0; r4 < R / 4; ++r4) { const f32x4 a = *(const LAS f32x4*)(A + k * R + 4 * r4);
                    acc[4 * r4] += a.x * w; acc[4 * r4 + 1] += a.y * w; acc[4 * r4 + 2] += a.z * w; acc[4 * r4 + 3] += a.w * w; } }
#pragma unroll
            for (int r = 0; r < R; ++r) OUT[r * 1024 + n] = acc[r];
        }
        __syncthreads();
        if (F.tid < R * MLA_H) {
            const int r = F.tid / MLA_H, h = F.tid % MLA_H, row = r0 + r;
            const LAS float* q = OUT + r * 1024 + h * MLA_QK;
            float ss = 0.f; for (int d = 0; d < MLA_QK; ++d) ss += q[d] * q[d];
            const float s = 1.f / sqrtf(ss * (1.f / MLA_QK) + EPS) * C2_MLA;
            bf16* dst = F_QM + (size_t)row * 768 + h * MLA_QK;
            for (int d = 0; d < MLA_NOPE; ++d) dst[d] = f2bf(q[d] * s * F_q_gain[d]);
            const float p = (float)F_pos[row];
            for (int i = 0; i < 16; ++i) {
                const float freq = exp2f(-13.287712379549449f * (float)i * (1.f / 16.f));
                float sn, cs; sincos_red(p * freq, sn, cs);
                const float x1 = q[64 + i] * s * F_q_gain[64 + i], x2 = q[80 + i] * s * F_q_gain[80 + i];
                dst[64 + i] = f2bf(x1 * cs - x2 * sn); dst[80 + i] = f2bf(x2 * cs + x1 * sn);
            }
        }
        __syncthreads();
        for (int i = F.tid; i < R * KVLORA; i += NTHR) { const int r = i / KVLORA, k = i % KVLORA; A[k * R + r] = bf2f(F_ZA[(size_t)(r0 + r) * ZA_LD + QLORA + k]); }
        __syncthreads();
        if (F.tid < R) { float ss = 0.f; for (int k = 0; k < KVLORA; ++k) { const float v = A[k * R + F.tid]; ss += v * v; } SC[F.tid] = 1.f / sqrtf(ss * (1.f / KVLORA) + EPS); }
        __syncthreads();
        for (int i = F.tid; i < R * KVLORA; i += NTHR) { const int r = i % R, k = i / R; A[k * R + r] *= SC[r] * F_kv_norm[k]; }
        __syncthreads();
        for (int n = F.tid; n < 1024; n += NTHR) {
            float acc[R];
#pragma unroll
            for (int r = 0; r < R; ++r) acc[r] = 0.f;
#pragma unroll 4
            for (int k = 0; k < KVLORA; ++k) { const float w = F_w_ukv[(size_t)k * 1024 + n];
#pragma unroll
                for (int r4 = 0; r4 < R / 4; ++r4) { const f32x4 a = *(const LAS f32x4*)(A + k * R + 4 * r4);
                    acc[4 * r4] += a.x * w; acc[4 * r4 + 1] += a.y * w; acc[4 * r4 + 2] += a.z * w; acc[4 * r4 + 3] += a.w * w; } }
#pragma unroll
            for (int r = 0; r < R; ++r) OUT[r * 1024 + n] = acc[r];
        }
        __syncthreads();
        if (F.tid < R * MLA_H) {
            const int r = F.tid / MLA_H, h = F.tid % MLA_H, row = r0 + r;
            const LAS float* kn = OUT + r * 1024 + h * 128;
            const bf16* kr = F_ZA + (size_t)row * ZA_LD + QLORA + KVLORA;
            float ss = 0.f; for (int d = 0; d < 64; ++d) ss += kn[d] * kn[d];
            for (int d = 0; d < 32; ++d) { const float v = bf2f(kr[d]); ss += v * v; }
            const float s = 1.f / sqrtf(ss * (1.f / MLA_QK) + EPS);
            bf16* dk = F_KM + (size_t)row * 768 + h * MLA_QK;
            for (int d = 0; d < 64; ++d) dk[d] = f2bf(kn[d] * s * F_k_gain[d]);
            const float p = (float)F_pos[row];
            for (int i = 0; i < 16; ++i) {
                const float freq = exp2f(-13.287712379549449f * (float)i * (1.f / 16.f));
                float sn, cs; sincos_red(p * freq, sn, cs);
                const float x1 = bf2f(kr[i]) * s * F_k_gain[64 + i], x2 = bf2f(kr[16 + i]) * s * F_k_gain[80 + i];
                dk[64 + i] = f2bf(x1 * cs - x2 * sn); dk[80 + i] = f2bf(x2 * cs + x1 * sn);
            }
            bf16* dv = F_VM + (size_t)row * 512 + h * 64;
            for (int d = 0; d < 64; ++d) dv[d] = f2bf(kn[64 + d]);
        }
        __syncthreads();
    }
}
__device__ __forceinline__ void ph_diff_prep(Frame& F) {
    const int gt = F.bid * NTHR + F.tid, NGT = F.G * NTHR;
    for (int it = gt; it < M * 16; it += NGT) {
        const int row = it >> 4, ch = it & 15;
        bf16* p = F_ZB + (size_t)row * ZB_LD + ch * 64;
        const bool isq = ch < 8;
        const float* gain = isq ? F_dq_gain : F_dk_gain;
        float ss = 0.f;
        for (int d = 0; d < 64; ++d) { const float v = bf2f(p[d]); ss += v * v; }
        const float s = 1.f / sqrtf(ss * (1.f / 64.f) + EPS) * (isq ? C2_DF : 1.f);
        const float ps = (float)F_pos[row];
        float o1[8], o2[8];
#pragma unroll
        for (int i = 0; i < 8; ++i) {
            const float freq = exp2f(-18.931568569324174f * (float)i * (1.f / 8.f));
            float sn, cs; sincos_red(ps * freq, sn, cs);
            const float x1 = bf2f(p[i]) * s * gain[i], x2 = bf2f(p[8 + i]) * s * gain[8 + i];
            o1[i] = x1 * cs - x2 * sn; o2[i] = x2 * cs + x1 * sn;
        }
        for (int d = 16; d < 64; ++d) p[d] = f2bf(bf2f(p[d]) * s * gain[d]);
#pragma unroll
        for (int i = 0; i < 8; ++i) { p[i] = f2bf(o1[i]); p[8 + i] = f2bf(o2[i]); }
    }
}

constexpr int TK = 16;
template <int DQK, int DV>
__device__ __forceinline__ void attn_sweep(Frame& F, const float (&q)[DQK / 4], float (&o)[DV / 4], float& m, float& l, const bf16* Kb, int ldk, const bf16* Vb, int ldv) {
    constexpr int QP = DQK / 4, VP = DV / 4;
    const int part = F.tid & 3;
    LAS float* KL = (LAS float*)F.lds;
    LAS float* VL = KL + TK * DQK;
    for (int t0 = 0; t0 < SEQ; t0 += TK) {
        __syncthreads();
        for (int i = F.tid; i < TK * DQK; i += NTHR) { const int j = i / DQK, d = i % DQK; KL[i] = bf2f(Kb[(size_t)(t0 + j) * ldk + d]); }
        for (int i = F.tid; i < TK * DV; i += NTHR) { const int j = i / DV, d = i % DV; VL[i] = bf2f(Vb[(size_t)(t0 + j) * ldv + d]); }
        __syncthreads();
#pragma unroll 2
        for (int j = 0; j < TK; ++j) {
            float a = 0.f;
#pragma unroll
            for (int d4 = 0; d4 < QP / 4; ++d4) { const f32x4 kv = *(const LAS f32x4*)(KL + j * DQK + part * QP + 4 * d4);
                a += q[4 * d4] * kv.x + q[4 * d4 + 1] * kv.y + q[4 * d4 + 2] * kv.z + q[4 * d4 + 3] * kv.w; }
            a += __shfl_xor(a, 1); a += __shfl_xor(a, 2);
            const float mn = fmaxf(m, a), alpha = exp2f(m - mn), p = exp2f(a - mn);
            l = l * alpha + p; m = mn;
#pragma unroll
            for (int d4 = 0; d4 < VP / 4; ++d4) { const f32x4 vv = *(const LAS f32x4*)(VL + j * DV + part * VP + 4 * d4);
                o[4 * d4] = o[4 * d4] * alpha + p * vv.x; o[4 * d4 + 1] = o[4 * d4 + 1] * alpha + p * vv.y;
                o[4 * d4 + 2] = o[4 * d4 + 2] * alpha + p * vv.z; o[4 * d4 + 3] = o[4 * d4 + 3] * alpha + p * vv.w; }
        }
    }
}
__device__ __forceinline__ void ph_attention(Frame& F) {
    const int part = F.tid & 3, qi = F.tid >> 2;
    for (int u = F.bid; u < 1536; u += F.G) {
        if (u < 1024) {
            const int b = u >> 7, h = (u >> 4) & 7, qc = u & 15;
            const int row = b * SEQ + qc * 128 + qi;
            float q[MLA_QK / 4], o[MLA_V / 4]; float m = -INFINITY, l = 0.f;
#pragma unroll
            for (int d = 0; d < MLA_QK / 4; ++d) q[d] = bf2f(F_QM[(size_t)row * 768 + h * MLA_QK + part * (MLA_QK / 4) + d]);
#pragma unroll
            for (int d = 0; d < MLA_V / 4; ++d) o[d] = 0.f;
            attn_sweep<MLA_QK, MLA_V>(F, q, o, m, l, F_KM + (size_t)b * SEQ * 768 + h * MLA_QK, 768, F_VM + (size_t)b * SEQ * 512 + h * 64, 512);
            const float il = 1.f / l;
#pragma unroll
            for (int d = 0; d < MLA_V / 4; ++d) F_OMD[(size_t)row * 1024 + h * 64 + part * (MLA_V / 4) + d] = f2bf(o[d] * il);
        } else {
            const int v = u - 1024, b = v >> 6, h = (v >> 4) & 3, qc = v & 15;
            const int row = b * SEQ + qc * 128 + qi;
            float lam;
            { float s1 = 0.f, s2 = 0.f; for (int d = 0; d < 64; ++d) { s1 += F_lq1[d] * F_lk1[d]; s2 += F_lq2[d] * F_lk2[d]; } lam = expf(s1) - expf(s2) + LAMBDA_INIT; }
            float q[DF_D / 4], o1[DF_V / 4], o[DF_V / 4];
            const bf16* Zb = F_ZB + (size_t)b * SEQ * ZB_LD;
            { float m = -INFINITY, l = 0.f;
#pragma unroll
              for (int d = 0; d < DF_D / 4; ++d) q[d] = bf2f(F_ZB[(size_t)row * ZB_LD + h * 128 + part * (DF_D / 4) + d]);
#pragma unroll
              for (int d = 0; d < DF_V / 4; ++d) o[d] = 0.f;
              attn_sweep<DF_D, DF_V>(F, q, o, m, l, Zb + 512 + h * 128, ZB_LD, Zb + 1024 + h * 128, ZB_LD);
              const float il = 1.f / l;
#pragma unroll
              for (int d = 0; d < DF_V / 4; ++d) o1[d] = o[d] * il; }
            { float m = -INFINITY, l = 0.f;
#pragma unroll
              for (int d = 0; d < DF_D / 4; ++d) q[d] = bf2f(F_ZB[(size_t)row * ZB_LD + h * 128 + 64 + part * (DF_D / 4) + d]);
#pragma unroll
              for (int d = 0; d < DF_V / 4; ++d) o[d] = 0.f;
              attn_sweep<DF_D, DF_V>(F, q, o, m, l, Zb + 512 + h * 128 + 64, ZB_LD, Zb + 1024 + h * 128, ZB_LD);
              const float il = lam / l;
#pragma unroll
              for (int d = 0; d < DF_V / 4; ++d) F_OMD[(size_t)row * 1024 + 512 + h * 128 + part * (DF_V / 4) + d] = f2bf(o1[d] - o[d] * il); }
        }
    }
}

#define ATT_LANE() int t_ = threadIdx.x; asm volatile("" : "+v"(t_)); const int wid = __builtin_amdgcn_readfirstlane(t_ >> 6), r32 = t_ & 31, hi = (t_ >> 5) & 1
__device__ __forceinline__ void ph_attention_mfma(Frame& F) {
    using namespace attn;
    const int vcu = (F.G % 8 == 0) ? (F.bid % 8) * (F.G / 8) + F.bid / 8 : F.bid;
    LAS char* lds = (LAS char*)F.lds;
    for (int it = vcu; it < 768; it += F.G) {
        if (it < 512) {
            const int bh = it >> 3, qb = it & 7, b = bh >> 3, h = bh & 7;
            const size_t row0 = (size_t)b * SEQ + qb * 256;
            f32x16 o[2]; float l;
            sweep<MLA_QK, MLA_V>(F_QM + row0 * 768 + h * MLA_QK, 768, F_KM + (size_t)b * SEQ * 768 + h * MLA_QK, 768, F_VM + (size_t)b * SEQ * 512 + h * MLA_V, 512, o, l, lds);
            ATT_LANE();
            float rli[16]; row_recip(l, rli, lds, wid, r32, hi);
            bf16* Ow = F_OMD + (row0 + wid * QBLK) * 1024 + h * MLA_V;
#pragma unroll
            for (int r = 0; r < 16; ++r) { const int orow = crow(r, hi);
#pragma unroll
                for (int d0 = 0; d0 < 2; ++d0) Ow[(size_t)orow * 1024 + d0 * 32 + r32] = f2bf(o[d0][r] * rli[r]); }
        } else {
            const int v = it - 512, bh = v >> 3, qb = v & 7, b = bh >> 2, h = bh & 3;
            const size_t row0 = (size_t)b * SEQ + qb * 256;
            f32x16 o[4]; float l;
            { const bf16* Zb = F_ZB + (size_t)b * SEQ * ZB_LD;
              sweep<DF_D, DF_V>(F_ZB + row0 * ZB_LD + h * 128, ZB_LD, Zb + 512 + h * 128, ZB_LD, Zb + 1024 + h * 128, ZB_LD, o, l, lds); }
            { ATT_LANE();
              bf16* Ow = F_OMD + (row0 + wid * QBLK) * 1024 + 512 + h * DF_V;
              float rli[16]; row_recip(l, rli, lds, wid, r32, hi);
#pragma unroll
              for (int r = 0; r < 16; ++r) { const int orow = crow(r, hi);
#pragma unroll
                  for (int d0 = 0; d0 < 4; ++d0) Ow[(size_t)orow * 1024 + d0 * 32 + r32] = f2bf(o[d0][r] * rli[r]); } }
            asm volatile("" ::: "memory");
            { const bf16* Zb = F_ZB + (size_t)b * SEQ * ZB_LD;
              sweep<DF_D, DF_V>(F_ZB + row0 * ZB_LD + h * 128 + 64, ZB_LD, Zb + 512 + h * 128 + 64, ZB_LD, Zb + 1024 + h * 128, ZB_LD, o, l, lds); }
            ATT_LANE();
            bf16* Ow = F_OMD + (row0 + wid * QBLK) * 1024 + 512 + h * DF_V;
            float lam;
            { float s1 = 0.f, s2 = 0.f; for (int d = 0; d < 64; ++d) { s1 += F_lq1[d] * F_lk1[d]; s2 += F_lq2[d] * F_lk2[d]; } lam = expf(s1) - expf(s2) + LAMBDA_INIT; }
            float rli[16]; row_recip(l, rli, lds, wid, r32, hi);
            float ss[16];
#pragma unroll
            for (int r = 0; r < 16; ++r) { const int orow = crow(r, hi); float s = 0.f; const float f = lam * rli[r];
#pragma unroll
                for (int d0 = 0; d0 < 4; ++d0) { const float dv = bf2f(Ow[(size_t)orow * 1024 + d0 * 32 + r32]) - o[d0][r] * f; o[d0][r] = dv; s += dv * dv; }
                ss[r] = s; }
#pragma unroll
            for (int r = 0; r < 16; ++r) { float s = ss[r];
                s += __shfl_xor(s, 1); s += __shfl_xor(s, 2); s += __shfl_xor(s, 4); s += __shfl_xor(s, 8); s += __shfl_xor(s, 16);
                ss[r] = 1.f / sqrtf(s * (1.f / 128.f) + EPS) * (1.f - LAMBDA_INIT); }
            float gsub[4];
#pragma unroll
            for (int d0 = 0; d0 < 4; ++d0) gsub[d0] = F_subln[d0 * 32 + r32];
#pragma unroll
            for (int r = 0; r < 16; ++r) { const int orow = crow(r, hi);
#pragma unroll
                for (int d0 = 0; d0 < 4; ++d0) Ow[(size_t)orow * 1024 + d0 * 32 + r32] = f2bf(o[d0][r] * ss[r] * gsub[d0]); }
        }
    }
}
__device__ __forceinline__ void ph_subln(Frame& F) {
    const int gt = F.bid * NTHR + F.tid, NGT = F.G * NTHR;
    for (int it = gt; it < M * 4; it += NGT) {
        bf16* p = F_OMD + (size_t)(it >> 2) * 1024 + 512 + (it & 3) * 128;
        float ss = 0.f;
        for (int d = 0; d < 128; ++d) { const float v = bf2f(p[d]); ss += v * v; }
        const float s = 1.f / sqrtf(ss * (1.f / 128.f) + EPS) * (1.f - LAMBDA_INIT);
        for (int d = 0; d < 128; ++d) p[d] = f2bf(bf2f(p[d]) * s * F_subln[d]);
    }
}

struct NEpiSwiglu { bf16* ACT; __device__ __forceinline__ void operator()(int row, int col, float g, float u) const { ACT[(size_t)row * DFF + col] = f2bf(silu_f(g) * u); } };
struct NEpiResid { float* H; const float* base; const float* MOD; int gt_off; float scale;
    __device__ __forceinline__ void operator()(int row, int col, float a, float) const { const int b = row / SEQ; H[(size_t)row * D + col] = base[(size_t)row * D + col] + scale * MOD[b * ADA + gt_off + col] * a; } };
struct NEpiZ { bf16 *ZA, *ZB, *ZG;
    __device__ __forceinline__ void operator()(int row, int col, float a, float) const {
        if (col < 672) ZA[(size_t)row * ZA_LD + col] = f2bf(a);
        else if (col < 2208) ZB[(size_t)row * ZB_LD + (col - 672)] = f2bf(a);
        else ZG[(size_t)row * ZG_LD + (col - 2208)] = f2bf(a); } };
struct NEpiMerge { bf16* MRG; const bf16* ZG;
    __device__ __forceinline__ void operator()(int row, int col, float ya, float yb) const {
        const float ga = sigmoid_f(bf2f(ZG[(size_t)row * ZG_LD + col])), gb = sigmoid_f(bf2f(ZG[(size_t)row * ZG_LD + 1024 + col]));
        MRG[(size_t)row * D + col] = f2bf(ga * ya + gb * yb); } };

constexpr int NPH = 16;

__global__ void __launch_bounds__(NTHR, 2) mk_fwd(Args args) {
    extern __shared__ __attribute__((aligned(16))) unsigned char lds_raw[];
    Frame F;
    F.lds = (LAS unsigned char*)lds_raw;
    F.tid = threadIdx.x; F.lane = F.tid & 63; F.wave = __builtin_amdgcn_readfirstlane(F.tid >> 6); F.G = gridDim.x; F.bid = blockIdx.x;
    unsigned char* ws = args.ws;
    F.in = args.in; F.ws = args.ws; F.H = args.out;

    for (int u = F.tid; u < (LDS_BYTES - LDSCTL_OFF) / 4; u += NTHR) ((LAS unsigned*)(F.lds + LDSCTL_OFF))[u] = 0u;
    __syncthreads();
    volatile LAS unsigned* MISC = (volatile LAS unsigned*)(F.lds + MISC_OFF);
    const bool multi = (args.ph_hi - args.ph_lo) > 1;
    XcdBarrier bar; bar.bar = (unsigned*)(ws + WS_CTL) + CW_BAR; bar.x = 0; bar.st = MISC + 8;
    if (multi) bar = xcd_barrier_post((unsigned*)(ws + WS_CTL) + CW_BAR, MISC + 8);

    const int lo = args.ph_lo, hi = args.ph_hi;
#define IN(k) (lo <= (k) && (k) < hi)
#define SEAM(k) do { if (IN(k) && IN((k) + 1)) xcd_barrier(bar); } while (0)
    const int gw = F.bid * NWAVES + F.wave, NGW = F.G * NWAVES;
    pg8::bf16_t* const WUP = (pg8::bf16_t*)(ws + WS_WUP); pg8::bf16_t* const WDN = (pg8::bf16_t*)(ws + WS_WDN);
    if (IN(0)) { ph_adaln(F); __syncthreads(); tr_ffn(F, F_ffn1_wg, F_ffn1_wu, F_ffn1_wd, gw, NGW); tr_misc(F, gw, NGW); } SEAM(0);
    if (IN(1)) { ph_norm_mod(F, F_x, F_ffn1_norm, 0 * D, 1 * D, F_XN); } SEAM(1);
    if (IN(2)) { pg8::Gemm g{F_XN, WUP, M, 2 * DFF, D, D, D}; pg8::StaticOrder S; S.init(M, 2 * DFF, F.G, F.bid);
        pg8::EpiSwiglu E{F_ACT, DFF}; pg8::gemm_phase<pg8::EpiSwiglu, pg8::StaticOrder, true, true>(F.lds, g, S, E); } SEAM(2);
    if (IN(3)) { pg8::Gemm g{F_ACT, WDN, M, D, DFF, DFF, DFF}; pg8::StaticOrder S; S.init(M, D, F.G, F.bid);
        pg8::EpiResid E{F_x, F.H, F_MOD + 2 * D, ADA, 0.5f}; pg8::gemm_phase<pg8::EpiResid, pg8::StaticOrder, false, true>(F.lds, g, S, E); } SEAM(3);
    if (IN(4)) { ph_norm_mod(F, F.H, F_mix_norm, 3 * D, 4 * D, F_XN); } SEAM(4);
    if (IN(5)) { pg8::Gemm g{F_XN, (pg8::bf16_t*)(ws + WS_WIN), M, 4352, D, D, D}; pg8::StaticOrder S; S.init(M, 4352, F.G, F.bid);
        pg8::EpiZ E{F_ZA, F_ZB, F_ZG, F_dq_gain, F_dk_gain, F_pos, (const float*)(ws + WS_TABD), C2_DF, EPS}; pg8::gemm_phase<pg8::EpiZ, pg8::StaticOrder, true, true>(F.lds, g, S, E); } SEAM(5);
    if (IN(6)) {
        { pg8::Gemm g{F_ZA, (pg8::bf16_t*)(ws + WS_WUQ), M, 768, QLORA, ZA_LD, QLORA}; pg8::StaticOrder S; S.init(M, 768, F.G, F.bid);
          pg8::EpiPlain E{F_QM, 768}; pg8::gemm_phase<pg8::EpiPlain, pg8::StaticOrder, true, true>(F.lds, g, S, E); }
        { pg8::Gemm g{F_ZA + QLORA, (pg8::bf16_t*)(ws + WS_WUKV), M, 1024, KVLORA, ZA_LD, KVLORA}; pg8::StaticOrder S; S.init(M, 1024, F.G, F.bid);
          pg8::EpiPlain E{(pg8::bf16_t*)(ws + WS_KVR), 1024}; pg8::gemm_phase<pg8::EpiPlain, pg8::StaticOrder, true, true>(F.lds, g, S, E); } } SEAM(6);
    if (IN(7)) { ph_mla_rowop(F); } SEAM(7);
    if (IN(8)) { ph_attention_mfma(F); } SEAM(8);
    if (IN(9)) { tr_ffn(F, F_ffn2_wg, F_ffn2_wu, F_ffn2_wd, gw, NGW); } SEAM(9);
    if (IN(10)) { pg8::StaticOrder S; S.init(M, D, F.G, F.bid);
        { pg8::Gemm g{F_OMD, (pg8::bf16_t*)(ws + WS_WO), M, D, 512, D, D}; pg8::EpiGate<0> E{F_MRG, F_ZG}; pg8::gemm_phase<pg8::EpiGate<0>, pg8::StaticOrder, false, true>(F.lds, g, S, E); }
        { pg8::Gemm g{F_OMD + 512, (pg8::bf16_t*)(ws + WS_WO) + 512, M, D, 512, D, D}; pg8::EpiGate<1> E{F_MRG, F_ZG}; pg8::gemm_phase<pg8::EpiGate<1>, pg8::StaticOrder, false, true>(F.lds, g, S, E); } } SEAM(10);
    if (IN(11)) { pg8::Gemm g{F_MRG, (pg8::bf16_t*)(ws + WS_WOUT), M, D, D, D, D}; pg8::StaticOrder S; S.init(M, D, F.G, F.bid);
        pg8::EpiResid E{F.H, F.H, F_MOD + 5 * D, ADA, 1.0f}; pg8::gemm_phase<pg8::EpiResid, pg8::StaticOrder, false, true>(F.lds, g, S, E); } SEAM(11);
    if (IN(12)) { ph_norm_mod(F, F.H, F_ffn2_norm, 6 * D, 7 * D, F_XN); } SEAM(12);
    if (IN(13)) { pg8::Gemm g{F_XN, WUP, M, 2 * DFF, D, D, D}; pg8::StaticOrder S; S.init(M, 2 * DFF, F.G, F.bid);
        pg8::EpiSwiglu E{F_ACT, DFF}; pg8::gemm_phase<pg8::EpiSwiglu, pg8::StaticOrder, true, true>(F.lds, g, S, E); } SEAM(13);
    if (IN(14)) { pg8::Gemm g{F_ACT, WDN, M, D, DFF, DFF, DFF}; pg8::StaticOrder S; S.init(M, D, F.G, F.bid);
        pg8::EpiResid E{F.H, F.H, F_MOD + 8 * D, ADA, 0.5f}; pg8::gemm_phase<pg8::EpiResid, pg8::StaticOrder, false, true>(F.lds, g, S, E); } SEAM(14);
    if (IN(15)) { ph_final_norm(F); }
#undef IN
#undef SEAM
}

#ifndef MK_ONE_LAUNCH
#define MK_ONE_LAUNCH 1
#endif

extern "C" void kernel_launch(void* const* d_in, const int* in_sizes, int n_in, void* d_out, int out_size, void* d_ws, size_t ws_size, hipStream_t stream) {
    static int grid = 0;
    if (grid == 0) {
        if (n_in != 32 || in_sizes[0] != M * D || out_size != M * D || ws_size < WS_TOP) {
            fprintf(stderr, "kernel_launch: unexpected shapes: n_in %d in0 %d out %d ws %zu (need %zu)\n", n_in, n_in > 0 ? in_sizes[0] : -1, out_size, ws_size, (size_t)WS_TOP); grid = -1; return; }
        int dev = 0, cus = 0, per_cu = 0;
        if (hipGetDevice(&dev) != hipSuccess || hipDeviceGetAttribute(&cus, hipDeviceAttributeMultiprocessorCount, dev) != hipSuccess) { grid = -1; return; }
        if (hipFuncSetAttribute((const void*)mk_fwd, hipFuncAttributeMaxDynamicSharedMemorySize, LDS_BYTES) != hipSuccess) { fprintf(stderr, "kernel_launch: hipFuncSetAttribute failed\n"); grid = -1; return; }
        if (hipOccupancyMaxActiveBlocksPerMultiprocessor(&per_cu, (const void*)mk_fwd, NTHR, LDS_BYTES) != hipSuccess || per_cu < 1) {
            fprintf(stderr, "kernel_launch: occupancy query says %d blocks per CU\n", per_cu); per_cu = 1; }
        (void)hipGetLastError();
        grid = cus;
    }
    if (grid < 0) return;
    if (hipMemsetAsync((char*)d_ws + WS_CTL, 0, CTL_ZERO_BYTES, stream) != hipSuccess) { fprintf(stderr, "kernel_launch: memset failed\n"); return; }
    Args a{};
    for (int i = 0; i < 32; ++i) a.in[i] = d_in[i];
    a.out = (float*)d_out; a.ws = (unsigned char*)d_ws;
#if MK_ONE_LAUNCH
    a.ph_lo = 0; a.ph_hi = NPH;
    hipLaunchKernelGGL(mk_fwd, dim3(grid), dim3(NTHR), LDS_BYTES, stream, a);
#else
    for (int p = 0; p < NPH; ++p) { a.ph_lo = p; a.ph_hi = p + 1; hipLaunchKernelGGL(mk_fwd, dim3(grid), dim3(NTHR), LDS_BYTES, stream, a); }
#endif
    const hipError_t le = hipPeekAtLastError();
    if (le != hipSuccess) fprintf(stderr, "kernel_launch: launch failed: %s\n", hipGetErrorName(le));
}
```
